# Optimizing an MI355X kernel written in HIP

```python
import math
import jax, jax.numpy as jnp
from jax import lax
import numpy as np

D_MODEL = 1024
BATCH = 8
SEQ = 4096
DEPTH = 4

N_MIXERS = 3
BLOCK = 128
NORM_EPS = 1e-6

SB_HEADS = 16
SB_HEAD_DIM = 64
SB_WIDTH = SB_HEADS * SB_HEAD_DIM

MLA_HEADS = 8
MLA_NOPE_DIM = 128
MLA_ROPE_DIM = 64
MLA_QK_DIM = MLA_NOPE_DIM + MLA_ROPE_DIM
MLA_V_DIM = 128
MLA_Q_RANK = 256
MLA_KV_RANK = 128
MLA_WIDTH = MLA_HEADS * MLA_V_DIM
ROPE_THETA = 10000.0

SWA_HEADS = 16
SWA_KV_HEADS = 4
SWA_GROUP = SWA_HEADS // SWA_KV_HEADS
SWA_HEAD_DIM = 64
SWA_WINDOW = 128
SWA_WIDTH = SWA_HEADS * SWA_HEAD_DIM

kernel_name = 'hybrid_sb_mla_swa_gated_trunk'


def rms_norm(x, g):
    xf = x.astype(jnp.float32)
    y = xf * lax.rsqrt(jnp.mean(xf * xf, axis=-1, keepdims=True) + NORM_EPS)
    return (y * g.astype(jnp.float32)).astype(x.dtype)


def rope(x, pos):
    half = x.shape[-1] // 2
    inv_freq = ROPE_THETA ** (-jnp.arange(half, dtype=jnp.float32) / half)
    ang = pos.astype(jnp.float32)[:, None] * inv_freq[None, :]
    cos = jnp.cos(ang)[None, :, None, :]
    sin = jnp.sin(ang)[None, :, None, :]
    xf = x.astype(jnp.float32)
    x1, x2 = xf[..., :half], xf[..., half:]
    out = jnp.concatenate([x1 * cos - x2 * sin, x2 * cos + x1 * sin], axis=-1)
    return out.astype(x.dtype)


def alibi_slopes(n_heads):
    return 2.0 ** (-8.0 * jnp.arange(1, n_heads + 1, dtype=jnp.float32) / n_heads)


def stick_breaking_attention(q, k, v):
    B, S, H, d = q.shape
    scale = 1.0 / math.sqrt(d)
    outs = []
    for i in range(S // BLOCK):
        t0 = i * BLOCK
        kl = t0 + BLOCK
        z = jnp.einsum('bthd,bshd->bhts', q[:, t0:kl], k[:, :kl]).astype(jnp.float32) * scale
        t_idx = t0 + jnp.arange(BLOCK)[:, None]
        s_idx = jnp.arange(kl)[None, :]
        mask = s_idx < t_idx
        log_fail = jnp.where(mask, jax.nn.log_sigmoid(-z), 0.0)
        later = lax.cumsum(log_fail, axis=3, reverse=True) - log_fail
        a = jnp.where(mask, jnp.exp(jax.nn.log_sigmoid(z) + later), 0.0)
        outs.append(jnp.einsum('bhts,bshd->bthd', a.astype(v.dtype), v[:, :kl]))
    return jnp.concatenate(outs, axis=1)


def causal_softmax_attention(q, k, v, scale):
    B, S, H, _ = q.shape
    outs = []
    for i in range(S // BLOCK):
        t0 = i * BLOCK
        kl = t0 + BLOCK
        s = jnp.einsum('bthd,bshd->bhts', q[:, t0:kl], k[:, :kl]).astype(jnp.float32) * scale
        mask = jnp.arange(kl)[None, :] <= (t0 + jnp.arange(BLOCK)[:, None])
        p = jax.nn.softmax(jnp.where(mask, s, -jnp.inf), axis=-1)
        outs.append(jnp.einsum('bhts,bshd->bthd', p.astype(v.dtype), v[:, :kl]))
    return jnp.concatenate(outs, axis=1)


def sliding_window_sink_attention(q, k, v, sinks):
    B, S, H, d = q.shape
    nb = S // BLOCK
    qb = q.reshape(B, nb, BLOCK, SWA_KV_HEADS, SWA_GROUP, d)

    def band(t):
        prev = jnp.pad(t, ((0, 0), (BLOCK, 0), (0, 0), (0, 0)))[:, :S]
        return jnp.concatenate([prev.reshape(B, nb, BLOCK, SWA_KV_HEADS, d),
                                t.reshape(B, nb, BLOCK, SWA_KV_HEADS, d)], axis=2)

    kb, vb = band(k), band(v)
    s = jnp.einsum('bnqkgd,bnskd->bnkgqs', qb, kb).astype(jnp.float32) / math.sqrt(d)
    rel = jnp.arange(BLOCK)[:, None] + BLOCK - jnp.arange(2 * BLOCK)[None, :]
    abs_s = jnp.arange(nb)[:, None] * BLOCK - BLOCK + jnp.arange(2 * BLOCK)[None, :]
    valid = ((rel >= 0) & (rel < SWA_WINDOW))[None, :, :] & (abs_s >= 0)[:, None, :]
    slopes = alibi_slopes(SWA_HEADS).reshape(SWA_KV_HEADS, SWA_GROUP)
    s = s - slopes[:, :, None, None] * rel.astype(jnp.float32)
    s = jnp.where(valid[None, :, None, None, :, :], s, -jnp.inf)
    sink = sinks.astype(jnp.float32).reshape(SWA_KV_HEADS, SWA_GROUP)[None, None, :, :, None, None]
    m = jnp.maximum(jnp.max(s, axis=-1, keepdims=True), sink)
    e = jnp.exp(s - m)
    p = e / (jnp.sum(e, axis=-1, keepdims=True) + jnp.exp(sink - m))
    o = jnp.einsum('bnkgqs,bnskd->bnqkgd', p.astype(v.dtype), vb)
    return o.reshape(B, S, H, d)


def stick_breaking_layer(x, norm_g, w_in, w_out):
    B, S, _ = x.shape
    proj = rms_norm(x, norm_g) @ w_in
    q, k, v, gate = jnp.split(proj, 4, axis=-1)
    q = q.reshape(B, S, SB_HEADS, SB_HEAD_DIM)
    k = k.reshape(B, S, SB_HEADS, SB_HEAD_DIM)
    v = v.reshape(B, S, SB_HEADS, SB_HEAD_DIM)
    o = stick_breaking_attention(q, k, v).reshape(B, S, SB_WIDTH)
    return x + (o * jax.nn.silu(gate)) @ w_out


def mla_layer(x, norm_g, w_in, q_a_norm, w_uq, kv_a_norm, w_ukv, q_head_norm, k_head_norm, w_out):
    B, S, _ = x.shape
    proj = rms_norm(x, norm_g) @ w_in
    c1 = MLA_Q_RANK
    c2 = c1 + MLA_KV_RANK
    c3 = c2 + MLA_ROPE_DIM
    q_lat, kv_lat, k_pe, gate = proj[..., :c1], proj[..., c1:c2], proj[..., c2:c3], proj[..., c3:]
    q = (rms_norm(q_lat, q_a_norm) @ w_uq).reshape(B, S, MLA_HEADS, MLA_QK_DIM)
    kv = (rms_norm(kv_lat, kv_a_norm) @ w_ukv).reshape(B, S, MLA_HEADS, MLA_NOPE_DIM + MLA_V_DIM)
    k_nope, v = kv[..., :MLA_NOPE_DIM], kv[..., MLA_NOPE_DIM:]
    k_pe = jnp.broadcast_to(k_pe[:, :, None, :], (B, S, MLA_HEADS, MLA_ROPE_DIM))
    k = jnp.concatenate([k_nope, k_pe], axis=-1)
    q = rms_norm(q, q_head_norm)
    k = rms_norm(k, k_head_norm)
    pos = jnp.arange(S)
    q = jnp.concatenate([q[..., :MLA_NOPE_DIM], rope(q[..., MLA_NOPE_DIM:], pos)], axis=-1)
    k = jnp.concatenate([k[..., :MLA_NOPE_DIM], rope(k[..., MLA_NOPE_DIM:], pos)], axis=-1)
    o = causal_softmax_attention(q, k, v, 1.0 / math.sqrt(MLA_QK_DIM)).reshape(B, S, MLA_WIDTH)
    return x + (o * jax.nn.silu(gate)) @ w_out


def swa_layer(x, norm_g, w_in, q_head_norm, k_head_norm, sinks, w_out):
    B, S, _ = x.shape
    proj = rms_norm(x, norm_g) @ w_in
    kv_w = SWA_KV_HEADS * SWA_HEAD_DIM
    c1 = SWA_WIDTH
    c2 = c1 + kv_w
    c3 = c2 + kv_w
    q = proj[..., :c1].reshape(B, S, SWA_HEADS, SWA_HEAD_DIM)
    k = proj[..., c1:c2].reshape(B, S, SWA_KV_HEADS, SWA_HEAD_DIM)
    v = proj[..., c2:c3].reshape(B, S, SWA_KV_HEADS, SWA_HEAD_DIM)
    gate = proj[..., c3:]
    q = rms_norm(q, q_head_norm)
    k = rms_norm(k, k_head_norm)
    o = sliding_window_sink_attention(q, k, v, sinks).reshape(B, S, SWA_WIDTH)
    return x + (o * jax.nn.silu(gate)) @ w_out


def _dense(key, fan_in, fan_out):
    return jax.random.normal(key, (fan_in, fan_out), jnp.float32) * fan_in ** -0.5


def _gain(key, n):
    return 1.0 + 0.02 * jax.random.normal(key, (n,), jnp.float32)


def setup_inputs(seed: int = 0) -> dict:
    key = jax.random.key(seed)
    ks = jax.random.split(key, 24)
    sb_in = 4 * SB_WIDTH
    mla_in = MLA_Q_RANK + MLA_KV_RANK + MLA_ROPE_DIM + MLA_WIDTH
    swa_in = SWA_WIDTH + 2 * SWA_KV_HEADS * SWA_HEAD_DIM + SWA_WIDTH
    return {
        'x': jax.random.normal(ks[0], (BATCH, SEQ, D_MODEL), jnp.float32),
        'l0_norm': _gain(ks[1], D_MODEL),
        'l0_w_in': _dense(ks[2], D_MODEL, sb_in),
        'l0_w_out': _dense(ks[3], SB_WIDTH, D_MODEL),
        'l1_norm': _gain(ks[4], D_MODEL),
        'l1_w_in': _dense(ks[5], D_MODEL, mla_in),
        'l1_q_a_norm': _gain(ks[6], MLA_Q_RANK),
        'l1_w_uq': _dense(ks[7], MLA_Q_RANK, MLA_HEADS * MLA_QK_DIM),
        'l1_kv_a_norm': _gain(ks[8], MLA_KV_RANK),
        'l1_w_ukv': _dense(ks[9], MLA_KV_RANK, MLA_HEADS * (MLA_NOPE_DIM + MLA_V_DIM)),
        'l1_q_head_norm': _gain(ks[10], MLA_QK_DIM),
        'l1_k_head_norm': _gain(ks[11], MLA_QK_DIM),
        'l1_w_out': _dense(ks[12], MLA_WIDTH, D_MODEL),
        'l2_norm': _gain(ks[13], D_MODEL),
        'l2_w_in': _dense(ks[14], D_MODEL, swa_in),
        'l2_q_head_norm': _gain(ks[15], SWA_HEAD_DIM),
        'l2_k_head_norm': _gain(ks[16], SWA_HEAD_DIM),
        'l2_sinks': 0.5 * jax.random.normal(ks[17], (SWA_HEADS,), jnp.float32),
        'l2_w_out': _dense(ks[18], SWA_WIDTH, D_MODEL),
        'l3_norm': _gain(ks[19], D_MODEL),
        'l3_w_in': _dense(ks[20], D_MODEL, sb_in),
        'l3_w_out': _dense(ks[21], SB_WIDTH, D_MODEL),
    }


def reference(x, l0_norm, l0_w_in, l0_w_out,
              l1_norm, l1_w_in, l1_q_a_norm, l1_w_uq, l1_kv_a_norm, l1_w_ukv,
              l1_q_head_norm, l1_k_head_norm, l1_w_out,
              l2_norm, l2_w_in, l2_q_head_norm, l2_k_head_norm, l2_sinks, l2_w_out,
              l3_norm, l3_w_in, l3_w_out):
    layer_params = [
        (l0_norm, l0_w_in, l0_w_out),
        (l1_norm, l1_w_in, l1_q_a_norm, l1_w_uq, l1_kv_a_norm, l1_w_ukv,
         l1_q_head_norm, l1_k_head_norm, l1_w_out),
        (l2_norm, l2_w_in, l2_q_head_norm, l2_k_head_norm, l2_sinks, l2_w_out),
        (l3_norm, l3_w_in, l3_w_out),
    ]
    mixers = (stick_breaking_layer, mla_layer, swa_layer)
    for i in range(DEPTH):
        x = mixers[i % N_MIXERS](x, *layer_params[i])
    return x
```

```cpp
#include <hip/hip_runtime.h>
#include <cstdio>
#include <cstdint>
#include <cmath>

typedef unsigned short bf16_t;

namespace cfg {
constexpr int B = 8, S = 4096, D = 1024, M = B * S;
constexpr float NORM_EPS = 1e-6f;
constexpr float LOG2E = 1.4426950408889634f;
constexpr float SB_QSCALE = 0.125f * LOG2E;
constexpr float SWA_QSCALE = 0.125f * LOG2E;
constexpr float MLA_QSCALE = 0.07216878364870323f * LOG2E;
constexpr size_t MiB = 1u << 20;
constexpr size_t WS_CTL = 0, CTL_ZERO_BYTES = 2 * MiB;
constexpr size_t WS_SSN = 468 * MiB;
constexpr size_t WS_RK = 2 * MiB;
constexpr size_t WS_SS = 256 * 1024;
constexpr size_t WS_SSQ = 3 * MiB;
constexpr size_t WS_SSKV = 3 * MiB + 512 * 1024;
constexpr size_t WS_ROPE = 4 * MiB;
constexpr size_t WS_GPERM = 5 * MiB;
constexpr size_t WS_W = 8 * MiB;
constexpr size_t WS_XB = 48 * MiB;
constexpr size_t WS_A = 112 * MiB;
constexpr size_t WS_B = 208 * MiB;
constexpr size_t WS_C = 304 * MiB;
constexpr size_t WS_G = 368 * MiB;
constexpr size_t WS_QL = 432 * MiB;
constexpr size_t WS_KV2 = 448 * MiB;
constexpr size_t WS_KR = 464 * MiB;
constexpr size_t WS_KVN = 472 * MiB;
constexpr size_t WS_END = 480 * MiB;
}

__host__ __device__ __forceinline__ float bf2f(bf16_t v) { return __builtin_bit_cast(float, (unsigned)v << 16); }
__host__ __device__ __forceinline__ bf16_t f2bf(float f) { unsigned u = __builtin_bit_cast(unsigned, f); return (bf16_t)((u + 0x7fffu + ((u >> 16) & 1u)) >> 16); }

__host__ __device__ __forceinline__ int kperm_inv(int k) { return (k & 3) | (((k >> 4) & 1) << 2) | (((k >> 2) & 3) << 3); }
__host__ __device__ __forceinline__ size_t kt_idx(int bh, int s, int d) { return ((((size_t)bh * 128 + (s >> 5)) * 4 + (d >> 4)) * 64 + 32 * ((d >> 3) & 1) + kperm_inv(s & 31)) * 8 + (d & 7); }
__host__ __device__ __forceinline__ size_t vt_idx(int bh, int d, int s) { return ((((size_t)bh * 128 + (s >> 5)) * 4 + ((d >> 5) * 2 + ((s >> 3) & 1))) * 64 + 32 * ((s >> 4) & 1) + (d & 31)) * 8 + (s & 7); }
namespace pg8 {
#define PG8_LAS __attribute__((address_space(3)))
typedef unsigned short bf16_t;
typedef short bf16x8 __attribute__((ext_vector_type(8)));
typedef float f32x4 __attribute__((ext_vector_type(4)));
typedef unsigned u32x4 __attribute__((ext_vector_type(4)));
constexpr int BM = 256, BK = 64, HALF = 128, HTB = HALF * BK * 2  , STAGE_BYTES = 8 * HTB, NXCD = 8, WGM = 8;

__host__ __device__ __forceinline__ int lds_byte(int r, int c) { const int st = (r >> 4) * 2 + (c >> 5), rr = r & 15, cc = c & 31, ob = rr * 64 + cc * 2; return st * 1024 + (ob ^ (((ob >> 9) & 1) << 5)); }
__host__ __device__ __forceinline__ void stage_rc(int b, int& R, int& C) { const int st = b / 1024, sb = b % 1024, swz = sb ^ (((sb >> 9) & 1) << 5); R = (st >> 1) * 16 + swz / 64; C = (st & 1) * 32 + (swz % 64) / 2; }
__host__ __device__ __forceinline__ int perm32(int rho) { const int n = rho >> 4, i = rho & 15; return 8 * (i >> 2) + 4 * n + (i & 3); }

struct Unit { int pm, pn; };
struct Gemm { const bf16_t* A; const bf16_t* Bt; int M, N, K; };

struct StaticOrder {
    int nM, nN, nwg, G, c;
    __host__ __device__ void init(int M, int N, int G_, int c_) { nM = M / BM; nN = N / BM; nwg = nM * nN; G = G_; c = c_; }
    __host__ __device__ bool next(int i, Unit& u) const {
        const long L = (long)i * G + c; if (L >= nwg) return false;
        int wgid = (int)L; { const int q = nwg / NXCD, r = nwg % NXCD, xcd = wgid % NXCD, off = wgid / NXCD; wgid = (xcd < r ? xcd * (q + 1) : r * (q + 1) + (xcd - r) * q) + off; }
        const int nig = WGM * nN, gid = wgid / nig, fm = gid * WGM, gsz = (nM - fm) < WGM ? (nM - fm) : WGM;
        u.pm = fm + ((wgid % nig) % gsz); u.pn = (wgid % nig) / gsz; return true;
    }
    __device__ __forceinline__ void a_ready(const Unit&) const {}
    __device__ __forceinline__ void done(const Unit&) const {}
};


__device__ __forceinline__ unsigned cvt_pk_bf16(float lo, float hi) { unsigned r; asm volatile("v_cvt_pk_bf16_f32 %0, %1, %2" : "=v"(r) : "v"(lo), "v"(hi)); return r; }
typedef unsigned u32x2 __attribute__((ext_vector_type(2)));
__device__ __forceinline__ u32x4 pack8(const f32x4 v0, const f32x4 v1) { u32x4 w; w.x = cvt_pk_bf16(v0[0], v0[1]); w.y = cvt_pk_bf16(v0[2], v0[3]); w.z = cvt_pk_bf16(v1[0], v1[1]); w.w = cvt_pk_bf16(v1[2], v1[3]); return w; }
__device__ __forceinline__ float hsum4(const f32x4 v) { return (v[0] + v[1]) + (v[2] + v[3]); }
__device__ __forceinline__ float dot4(const f32x4 v) { return (v[0] * v[0] + v[1] * v[1]) + (v[2] * v[2] + v[3] * v[3]); }
__device__ __forceinline__ float rs_from16(const float* ss, int row) { return __builtin_amdgcn_rsqf(ss[row] * (1.0f / 1024.0f) + cfg::NORM_EPS); }
__device__ __forceinline__ float rs_from4(const float* ss, int row, float inv_n) {
    const f32x4 s = *(const f32x4*)(ss + (size_t)row * 4);
    return __builtin_amdgcn_rsqf(hsum4(s) * inv_n + cfg::NORM_EPS);
}

struct EpiSbQKG {
    static constexpr bool PERM = true, AFTER_DRAIN = false;
    const float* ss; unsigned char* ws;
    __device__ __forceinline__ void operator()(const f32x4 (&acc)[2][2][4][2], const Unit& u, int wr, int wc, int fr, int fq) const {
        const int t = u.pn >> 2;
        bf16_t* base = (bf16_t*)(ws + (t == 0 ? cfg::WS_A : (t == 1 ? cfg::WS_B : cfg::WS_G)));
        const float sc = t == 0 ? cfg::SB_QSCALE : 1.0f;
        const int col0 = (u.pn & 3) * BM + wc * 32 + 8 * fq, row0 = u.pm * BM + wr * 64 + fr;
#pragma unroll
        for (int ai = 0; ai < 2; ++ai)
#pragma unroll
            for (int m = 0; m < 4; ++m) { const int row = row0 + ai * HALF + m * 16; const float r = rs_from16(ss, row) * sc;
#pragma unroll
                for (int bj = 0; bj < 2; ++bj) { const int c = col0 + bj * HALF;
                    bf16_t* dst = t == 1 ? base + kt_idx((row >> 12) * 16 + (c >> 6), row & 4095, c & 63) : base + (size_t)row * 1024 + c;
                    *(u32x4*)dst = pack8(acc[ai][bj][m][0] * r, acc[ai][bj][m][1] * r); } }
    }
};
struct EpiVt {
    static constexpr bool PERM = true, AFTER_DRAIN = false;
    const float* ss; bf16_t* Vt; int nheads;
    __device__ __forceinline__ void operator()(const f32x4 (&acc)[2][2][4][2], const Unit& u, int wr, int wc, int fr, int fq) const {
        const int tok0 = u.pn * BM + wc * 32 + 8 * fq, r0 = u.pm * BM + wr * 64 + fr;
#pragma unroll
        for (int bj = 0; bj < 2; ++bj) { const int tok = tok0 + bj * HALF, b = tok >> 12, s = tok & 4095;
            f32x4 ra, rb;
#pragma unroll
            for (int j = 0; j < 4; ++j) { ra[j] = rs_from16(ss, tok + j); rb[j] = rs_from16(ss, tok + 4 + j); }
#pragma unroll
            for (int ai = 0; ai < 2; ++ai)
#pragma unroll
                for (int m = 0; m < 4; ++m) { const int r = r0 + ai * HALF + m * 16;
                    *(u32x4*)(Vt + vt_idx(b * nheads + (r >> 6), r & 63, s)) = pack8(acc[ai][bj][m][0] * ra, acc[ai][bj][m][1] * rb); } }
    }
};
template <bool XF32IN, bool F32OUT> struct EpiOutR {
    static constexpr bool PERM = true, AFTER_DRAIN = false;
    const float* xin; float* out; bf16_t* xb; float* ss;
    __device__ __forceinline__ void operator()(const f32x4 (&acc)[2][2][4][2], const Unit& u, int wr, int wc, int fr, int fq) const {
        const int col0 = u.pn * BM + wc * 32 + 8 * fq, row0 = u.pm * BM + wr * 64 + fr;
#pragma unroll
        for (int ai = 0; ai < 2; ++ai) {
            u32x4 xw[4][2]; f32x4 xf[4][2][2];
#pragma unroll
            for (int m = 0; m < 4; ++m)
#pragma unroll
                for (int bj = 0; bj < 2; ++bj) { const size_t o = (size_t)(row0 + ai * HALF + m * 16) * 1024 + col0 + bj * HALF;
                    if (XF32IN) { xf[m][bj][0] = *(const f32x4*)(xin + o); xf[m][bj][1] = *(const f32x4*)(xin + o + 4); } else xw[m][bj] = *(const u32x4*)(xb + o); }
#pragma unroll
            for (int m = 0; m < 4; ++m) { const int row = row0 + ai * HALF + m * 16; const size_t off = (size_t)row * 1024 + col0; float sq = 0.f;
#pragma unroll
                for (int bj = 0; bj < 2; ++bj) { const size_t o = off + bj * HALF; f32x4 x0, x1;
                    if (XF32IN) { x0 = xf[m][bj][0]; x1 = xf[m][bj][1]; }
                    else { const u32x4 w = xw[m][bj]; x0 = (f32x4){__uint_as_float(w.x << 16), __uint_as_float(w.x & 0xffff0000u), __uint_as_float(w.y << 16), __uint_as_float(w.y & 0xffff0000u)};
                           x1 = (f32x4){__uint_as_float(w.z << 16), __uint_as_float(w.z & 0xffff0000u), __uint_as_float(w.w << 16), __uint_as_float(w.w & 0xffff0000u)}; }
                    const f32x4 v0 = x0 + acc[ai][bj][m][0], v1 = x1 + acc[ai][bj][m][1];
                    if (F32OUT) { *(f32x4*)(out + o) = v0; *(f32x4*)(out + o + 4) = v1; }
                    else { *(u32x4*)(xb + o) = pack8(v0, v1); sq += dot4(v0) + dot4(v1); } }
                if (!F32OUT) { sq += __shfl_xor(sq, 16); sq += __shfl_xor(sq, 32); if (fq == 0) atomicAdd(ss + row, sq); } }
            asm volatile("" ::: "memory"); }
    }
};
struct EpiMlaIn {
    static constexpr bool PERM = true, AFTER_DRAIN = false;
    const float* ss; unsigned char* ws;
    __device__ __forceinline__ void operator()(const f32x4 (&acc)[2][2][4][2], const Unit& u, int wr, int wc, int fr, int fq) const {
        const int pn = u.pn;
        bf16_t* base = (bf16_t*)(ws + (pn == 0 ? cfg::WS_QL : (pn < 5 ? cfg::WS_G : cfg::WS_KV2)));
        float* sqdst = (float*)(ws + (pn == 0 ? cfg::WS_SSQ : cfg::WS_SSKV));
        const int ld = (pn == 0 || pn == 5) ? 256 : 1024, cbase = (pn == 0 || pn == 5) ? 0 : (pn - 1) * BM;
        const int col0 = cbase + wc * 32 + 8 * fq, row0 = u.pm * BM + wr * 64 + fr;
#pragma unroll
        for (int ai = 0; ai < 2; ++ai)
#pragma unroll
            for (int m = 0; m < 4; ++m) { const int row = row0 + ai * HALF + m * 16; const float r = rs_from16(ss, row); bf16_t* rowp = base + (size_t)row * ld + col0;
                float sq[2];
#pragma unroll
                for (int bj = 0; bj < 2; ++bj) { const f32x4 v0 = acc[ai][bj][m][0] * r, v1 = acc[ai][bj][m][1] * r; sq[bj] = dot4(v0) + dot4(v1); *(u32x4*)(rowp + bj * HALF) = pack8(v0, v1); }
                if (pn == 0 || pn == 5) { float s = pn == 0 ? sq[0] + sq[1] : sq[0]; s += __shfl_xor(s, 16); s += __shfl_xor(s, 32);
                    if (fq == 0) sqdst[(size_t)row * 4 + wc] = s; } }
    }
};
struct EpiUq {
    static constexpr bool PERM = true, AFTER_DRAIN = false;
    const float* ssq; bf16_t* Qm;
    __device__ __forceinline__ void operator()(const f32x4 (&acc)[2][2][4][2], const Unit& u, int wr, int wc, int fr, int fq) const {
        const int col0 = u.pn * BM + wc * 32 + 8 * fq, row0 = u.pm * BM + wr * 64 + fr;
#pragma unroll
        for (int ai = 0; ai < 2; ++ai)
#pragma unroll
            for (int m = 0; m < 4; ++m) { const int row = row0 + ai * HALF + m * 16; const float r = rs_from4(ssq, row, 1.0f / 256.0f); bf16_t* rowp = Qm + (size_t)row * 1536 + col0;
#pragma unroll
                for (int bj = 0; bj < 2; ++bj) *(u32x4*)(rowp + bj * HALF) = pack8(acc[ai][bj][m][0] * r, acc[ai][bj][m][1] * r); }
    }
};
struct EpiUkv {
    static constexpr bool PERM = true, AFTER_DRAIN = false;
    const float* sskv; bf16_t* Kn; bf16_t* Vm; float* ssn;
    __device__ __forceinline__ void operator()(const f32x4 (&acc)[2][2][4][2], const Unit& u, int wr, int wc, int fr, int fq) const {
        const int row0 = u.pm * BM + wr * 64 + fr;
#pragma unroll
        for (int ai = 0; ai < 2; ++ai)
#pragma unroll
            for (int m = 0; m < 4; ++m) { const int row = row0 + ai * HALF + m * 16; const float r = rs_from4(sskv, row, 1.0f / 128.0f);
#pragma unroll
                for (int bj = 0; bj < 2; ++bj) { const f32x4 k0 = acc[ai][bj][m][0] * r, k1 = acc[ai][bj][m][1] * r;
                    float sq = dot4(k0) + dot4(k1); sq += __shfl_xor(sq, 16); sq += __shfl_xor(sq, 32);
                    if (fq == 0) ssn[((size_t)row * 8 + 2 * u.pn + bj) * 4 + wc] = sq; } }
    }
};
struct EpiSwaQKG {
    static constexpr bool PERM = true, AFTER_DRAIN = false;
    const float* ss; const float* gq; const float* gk; unsigned char* ws;
    __device__ __forceinline__ void operator()(const f32x4 (&acc)[2][2][4][2], const Unit& u, int wr, int wc, int fr, int fq) const {
        const int pn = u.pn; const bool normed = pn < 5;
        bf16_t* base = (bf16_t*)(ws + (pn < 4 ? cfg::WS_A : (pn == 4 ? cfg::WS_B : cfg::WS_G)));
        const int ld = pn == 4 ? 256 : 1024, cbase = pn < 4 ? pn * BM : (pn == 4 ? 0 : (pn - 5) * BM);
        const int col0 = cbase + wc * 64 + 8 * fq, row0 = u.pm * BM + wr * 64 + fr;
        f32x4 gv[2][2];
#pragma unroll
        for (int bj = 0; bj < 2; ++bj)
#pragma unroll
            for (int n = 0; n < 2; ++n) { gv[bj][n] = (f32x4){1.f, 1.f, 1.f, 1.f};
                const f32x4 a = *(const f32x4*)(gq + 32 * bj + 8 * fq + 4 * n) * cfg::SWA_QSCALE, b = *(const f32x4*)(gk + 32 * bj + 8 * fq + 4 * n);
                if (normed) gv[bj][n] = pn < 4 ? a : b; }
#pragma unroll
        for (int ai = 0; ai < 2; ++ai)
#pragma unroll
            for (int m = 0; m < 4; ++m) { const int row = row0 + ai * HALF + m * 16; float r = rs_from16(ss, row); bf16_t* rowp = base + (size_t)row * ld + col0;
                if (normed) { float sq = (dot4(acc[ai][0][m][0]) + dot4(acc[ai][0][m][1])) + (dot4(acc[ai][1][m][0]) + dot4(acc[ai][1][m][1]));
                    sq += __shfl_xor(sq, 16); sq += __shfl_xor(sq, 32);
                    r = r * __builtin_amdgcn_rsqf(sq * r * r * (1.0f / 64.0f) + cfg::NORM_EPS); }
#pragma unroll
                for (int bj = 0; bj < 2; ++bj) { bf16_t* dst = pn == 4 ? base + kt_idx((row >> 12) * 4 + wc, row & 4095, 32 * bj + 8 * fq) : rowp + bj * 32;
                    *(u32x4*)dst = pack8(acc[ai][bj][m][0] * r * gv[bj][0], acc[ai][bj][m][1] * r * gv[bj][1]); } }
    }
};

template <class Epi, class Sched, bool ALIGN_EPI = false, bool SP2 = false>
__device__ __forceinline__ void gemm_phase(PG8_LAS unsigned char* lds, const Gemm g, const Sched& S, const Epi& E) {
    int tid_ = threadIdx.x; asm volatile("" : "+v"(tid_));
    const int tid = tid_, wid = __builtin_amdgcn_readfirstlane(tid >> 6), lane = tid & 63, wr = wid >> 2, wc = wid & 3, fr = lane & 15, fq = lane >> 4;
    const int K = g.K, nt = K / BK;
    unsigned voffA[2], voffB[2];
#pragma unroll
    for (int i = 0; i < 2; ++i) { int R, C; stage_rc(tid * 16 + i * 8192, R, C); const int Rb = Epi::PERM ? ((R & ~31) + perm32(R & 31)) : R;
        voffA[i] = (unsigned)(R * K + C) * 2u; voffB[i] = (unsigned)(Rb * K + C) * 2u; }
    const size_t kstep = (size_t)(BK * 2);
    const size_t hstep = (size_t)HALF * K * 2;
    const size_t tstep = 2 * hstep;
    const unsigned ldsw = (unsigned)wid * 1024u;
    const int aoff = lds_byte(wr * 64 + fr, fq * 8), boff = lds_byte(wc * 32 + fr, fq * 8);
#define PG8_SA(b, h) (((b) * 2 + (h)) * HTB)
#define PG8_SB(b, h) ((4 + (b) * 2 + (h)) * HTB)
#define PG8_STAGE(bufoff, gbase, voff) do { _Pragma("unroll") for (int _i = 0; _i < 2; ++_i) \
        __builtin_amdgcn_global_load_lds((const unsigned*)((const char*)(gbase) + (voff)[_i]), (PG8_LAS unsigned*)(lds + (bufoff) + ldsw + _i * 8192), 16, 0, 0); } while (0)
#define PG8_LDA(dst, b, h) do { _Pragma("unroll") for (int m = 0; m < 4; ++m) _Pragma("unroll") for (int k = 0; k < 2; ++k) dst[m][k] = *(const PG8_LAS bf16x8*)(lds + PG8_SA(b, h) + aoff + m * 2048 + k * 1024); } while (0)
#define PG8_LDB(dst, b, h) do { _Pragma("unroll") for (int n = 0; n < 2; ++n) _Pragma("unroll") for (int k = 0; k < 2; ++k) dst[n][k] = *(const PG8_LAS bf16x8*)(lds + PG8_SB(b, h) + boff + n * 2048 + k * 1024); } while (0)
#define PG8_MMA(ai, bj, At, Bt) do { __builtin_amdgcn_s_setprio(1); _Pragma("unroll") for (int m = 0; m < 4; ++m) _Pragma("unroll") for (int n = 0; n < 2; ++n) _Pragma("unroll") for (int k = 0; k < 2; ++k) \
        acc[ai][bj][m][n] = __builtin_amdgcn_mfma_f32_16x16x32_bf16(Bt[n][k], At[m][k], acc[ai][bj][m][n], 0, 0, 0); __builtin_amdgcn_s_setprio(0); } while (0)
#define PG8_WAIT_V(n) asm volatile("s_waitcnt vmcnt(" #n ")" ::: "memory")
#define PG8_WAIT_L(n) asm volatile("s_waitcnt lgkmcnt(" #n ")" ::: "memory")
#define PG8_BAR __builtin_amdgcn_s_barrier()
#define PG8_SCHED __builtin_amdgcn_sched_barrier(0)
    Unit cur, nxt; int ui = 0;
    if (!S.next(0, cur)) return;
    f32x4 acc[2][2][4][2];
#pragma unroll
    for (int a = 0; a < 2; ++a)
#pragma unroll
        for (int b = 0; b < 2; ++b)
#pragma unroll
            for (int m = 0; m < 4; ++m)
#pragma unroll
                for (int n = 0; n < 2; ++n) acc[a][b][m][n] = (f32x4){0.f, 0.f, 0.f, 0.f};
    bf16x8 At[4][2], B0[2][2], B1[2][2];
    const char* cA = (const char*)g.A + (size_t)cur.pm * tstep; const char* cB = (const char*)g.Bt + (size_t)cur.pn * tstep;
    S.a_ready(cur);
    if constexpr (SP2) {
        PG8_STAGE(PG8_SB(0, 0), cB, voffB); PG8_STAGE(PG8_SB(0, 1), cB + hstep, voffB); PG8_STAGE(PG8_SA(0, 0), cA, voffA); PG8_STAGE(PG8_SA(0, 1), cA + hstep, voffA);
        if (wr == 1) PG8_BAR;
        PG8_WAIT_V(2); PG8_BAR;
        PG8_STAGE(PG8_SB(1, 0), cB + kstep, voffB); PG8_STAGE(PG8_SA(1, 0), cA + kstep, voffA); PG8_STAGE(PG8_SB(1, 1), cB + hstep + kstep, voffB);
        PG8_WAIT_V(6); PG8_BAR;
    } else {
        PG8_STAGE(PG8_SB(0, 0), cB, voffB); PG8_STAGE(PG8_SA(0, 0), cA, voffA); PG8_STAGE(PG8_SB(0, 1), cB + hstep, voffB); PG8_STAGE(PG8_SA(0, 1), cA + hstep, voffA);
        if (wr == 1) PG8_BAR;
        PG8_WAIT_V(4); PG8_BAR;
        PG8_STAGE(PG8_SB(1, 0), cB + kstep, voffB); PG8_STAGE(PG8_SA(1, 0), cA + kstep, voffA); PG8_STAGE(PG8_SB(1, 1), cB + hstep + kstep, voffB);
        PG8_WAIT_V(6); PG8_BAR;
    }
    for (;;) {
        const bool has_next = S.next(ui + 1, nxt);
        const char* nA = has_next ? (const char*)g.A + (size_t)nxt.pm * tstep : cA; const char* nB = has_next ? (const char*)g.Bt + (size_t)nxt.pn * tstep : cB;
        for (int t = 0; t < nt; t += 2) {
            const bool last = (t == nt - 2);
            const char* a1 = cA + (size_t)(t + 1) * kstep;
            const char* a2 = last ? nA : cA + (size_t)(t + 2) * kstep; const char* b2 = last ? nB : cB + (size_t)(t + 2) * kstep;
            const char* a3 = a2 + kstep; const char* b3 = b2 + kstep;
            if (last && has_next) S.a_ready(nxt);
            if constexpr (SP2) {
            PG8_LDB(B0, 0, 0); PG8_LDB(B1, 0, 1); PG8_SCHED; PG8_LDA(At, 0, 0); PG8_STAGE(PG8_SA(1, 1), a1 + hstep, voffA);
            PG8_WAIT_V(8); PG8_WAIT_L(0); PG8_BAR; PG8_MMA(0, 0, At, B0); PG8_MMA(0, 1, At, B1); PG8_BAR; PG8_SCHED;
            PG8_LDA(At, 0, 1); PG8_STAGE(PG8_SB(0, 0), b2, voffB); PG8_STAGE(PG8_SB(0, 1), b2 + hstep, voffB); PG8_STAGE(PG8_SA(0, 0), a2, voffA);
            PG8_WAIT_V(8); PG8_WAIT_L(0); PG8_BAR; PG8_MMA(1, 0, At, B0); PG8_MMA(1, 1, At, B1); PG8_BAR; PG8_SCHED;
            PG8_LDB(B0, 1, 0); PG8_LDB(B1, 1, 1); PG8_SCHED; PG8_LDA(At, 1, 0); PG8_STAGE(PG8_SA(0, 1), a2 + hstep, voffA);
            PG8_WAIT_V(8); PG8_WAIT_L(0); PG8_BAR; PG8_MMA(0, 0, At, B0); PG8_MMA(0, 1, At, B1); PG8_BAR; PG8_SCHED;
            PG8_LDA(At, 1, 1); PG8_STAGE(PG8_SB(1, 0), b3, voffB); PG8_STAGE(PG8_SB(1, 1), b3 + hstep, voffB); PG8_STAGE(PG8_SA(1, 0), a3, voffA);
            PG8_WAIT_V(8); PG8_WAIT_L(0); PG8_BAR; PG8_MMA(1, 0, At, B0); PG8_MMA(1, 1, At, B1); PG8_BAR; PG8_SCHED;
            } else {
            PG8_LDB(B0, 0, 0); PG8_SCHED; PG8_LDA(At, 0, 0); PG8_STAGE(PG8_SA(1, 1), a1 + hstep, voffA);
            PG8_WAIT_L(8); PG8_BAR; PG8_WAIT_L(0); PG8_MMA(0, 0, At, B0); PG8_BAR; PG8_SCHED;
            PG8_LDB(B1, 0, 1); PG8_STAGE(PG8_SB(0, 0), b2, voffB);
            PG8_BAR; PG8_WAIT_L(0); PG8_MMA(0, 1, At, B1); PG8_BAR;
            PG8_LDA(At, 0, 1); PG8_STAGE(PG8_SA(0, 0), a2, voffA);
            PG8_BAR; PG8_WAIT_L(0); PG8_MMA(1, 0, At, B0); PG8_BAR; PG8_SCHED;
            PG8_STAGE(PG8_SB(0, 1), b2 + hstep, voffB);
            PG8_WAIT_V(6); PG8_BAR; PG8_MMA(1, 1, At, B1); PG8_BAR;
            PG8_LDB(B0, 1, 0); PG8_SCHED; PG8_LDA(At, 1, 0); PG8_STAGE(PG8_SA(0, 1), a2 + hstep, voffA);
            PG8_WAIT_L(8); PG8_BAR; PG8_WAIT_L(0); PG8_MMA(0, 0, At, B0); PG8_BAR; PG8_SCHED;
            PG8_LDB(B1, 1, 1); PG8_STAGE(PG8_SB(1, 0), b3, voffB);
            PG8_BAR; PG8_WAIT_L(0); PG8_MMA(0, 1, At, B1); PG8_BAR;
            PG8_LDA(At, 1, 1); PG8_STAGE(PG8_SA(1, 0), a3, voffA);
            PG8_BAR; PG8_WAIT_L(0); PG8_MMA(1, 0, At, B0); PG8_BAR; PG8_SCHED;
            PG8_STAGE(PG8_SB(1, 1), b3 + hstep, voffB);
            PG8_WAIT_V(6); PG8_BAR; PG8_MMA(1, 1, At, B1); PG8_BAR;
            }
        }
        if constexpr (ALIGN_EPI) { if (wr == 0) PG8_BAR; }
        if constexpr (!Epi::AFTER_DRAIN) { E(acc, cur, wr, wc, fr, fq); S.done(cur); }
        if (!has_next) break;
#pragma unroll
        for (int a = 0; a < 2; ++a)
#pragma unroll
            for (int b = 0; b < 2; ++b)
#pragma unroll
                for (int m = 0; m < 4; ++m)
#pragma unroll
                    for (int n = 0; n < 2; ++n) acc[a][b][m][n] = (f32x4){0.f, 0.f, 0.f, 0.f};
        cur = nxt; cA = nA; cB = nB; ++ui;
        if constexpr (ALIGN_EPI) { if (wr == 1) PG8_BAR; }
    }
    PG8_WAIT_V(0);
    if constexpr (!ALIGN_EPI) { if (wr == 0) PG8_BAR; }
    PG8_BAR;
    if constexpr (Epi::AFTER_DRAIN) { E.fused(acc, cur, wr, wc, fr, fq, lds, wid, lane); S.done(cur); }
#undef PG8_SA
#undef PG8_SB
#undef PG8_STAGE
#undef PG8_LDA
#undef PG8_LDB
#undef PG8_MMA
#undef PG8_WAIT_V
#undef PG8_WAIT_L
#undef PG8_BAR
#undef PG8_SCHED
}
}

constexpr int NWAVES = 8;
constexpr int N_PHASES = 15;
constexpr int RING_OFF = 0, RING_BYTES = 159744;
constexpr int LDSCTL_OFF = RING_BYTES, MISC_OFF = LDSCTL_OFF + 320;
constexpr int LDS_BYTES = 163840;
constexpr int CW_BAR = 4096;

#define GAS __attribute__((address_space(1)))
#define LAS __attribute__((address_space(3)))
typedef unsigned v4u __attribute__((ext_vector_type(4)));
typedef float f32x4 __attribute__((ext_vector_type(4)));
typedef GAS unsigned gu32;
#define RLX_AGENT __ATOMIC_RELAXED, __HIP_MEMORY_SCOPE_AGENT
#define LDS_WAIT() asm volatile("s_waitcnt lgkmcnt(0)" ::: "memory")
#define VM_WAIT() asm volatile("s_waitcnt vmcnt(0)" ::: "memory")
__device__ __forceinline__ unsigned pk2(float lo, float hi) { return (unsigned)f2bf(lo) | ((unsigned)f2bf(hi) << 16); }

#define XB_TMO      128
#define XB_XCNT(j)  (256  + 64 * (j))
#define XB_XSUB(j)  (1280 + 64 * (j))
#define XB_XGEN(j)  (2304 + 64 * (j))
#define XB_TOP      3328
#define XB_TOPGEN   3392
#define XCD_BAR_WORDS 3456
#define XB_SPIN_CAP (1u << 18)

__device__ __forceinline__ unsigned xb_ld(unsigned* p)              { return __hip_atomic_load(p, __ATOMIC_RELAXED, __HIP_MEMORY_SCOPE_AGENT); }
__device__ __forceinline__ unsigned xb_add(unsigned* p, unsigned v) { return __hip_atomic_fetch_add(p, v, __ATOMIC_RELAXED, __HIP_MEMORY_SCOPE_AGENT); }
__device__ __forceinline__ unsigned xb_xcc_id() { return (unsigned)__builtin_amdgcn_s_getreg((3 << 11) | 20) & 0xFu; }
#define XB_SPIN(cond, bar) do { unsigned _sp = 0; while (cond) { __builtin_amdgcn_s_sleep(1); \
    if ((++_sp & 255u) == 0u) { if (xb_ld(&(bar)[XB_TMO])) break; if (_sp > XB_SPIN_CAP) { atomicAdd(&(bar)[XB_TMO], 1u); break; } } } } while (0)

struct XcdBarrier {
    unsigned* bar; unsigned x;
    volatile LAS unsigned* st;
};

__device__ __forceinline__ XcdBarrier xcd_barrier_post(unsigned* bar, volatile LAS unsigned* st) {
    XcdBarrier b; b.bar = bar; b.x = xb_xcc_id(); b.st = st;
    if (threadIdx.x == 0) (void)xb_add(&bar[XB_XCNT(b.x)], 1u);
    return b;
}
__device__ __forceinline__ void xcd_barrier_complete(unsigned* bar, unsigned x, unsigned& nloc, unsigned& nx) {
    const unsigned G = gridDim.x * gridDim.y * gridDim.z;
    unsigned sum, cnt, mine, sp = 0u;
    for (;;) {
        sum = 0u; cnt = 0u; mine = 0u;
#pragma unroll
        for (unsigned j = 0; j < 16; ++j) { const unsigned c = xb_ld(&bar[XB_XCNT(j)]); sum += c; cnt += (c > 0u) ? 1u : 0u; mine = (j == x) ? c : mine; }
        if (sum == G) break;
        __builtin_amdgcn_s_sleep(1);
        if ((++sp & 255u) == 0u) { if (xb_ld(&bar[XB_TMO])) break; if (sp > XB_SPIN_CAP) { atomicAdd(&bar[XB_TMO], 1u); break; } }
    }
    nloc = mine > 0u ? mine : 1u; nx = cnt > 0u ? cnt : 1u;
}

__device__ __forceinline__ void xcd_barrier(const XcdBarrier& b) {
    asm volatile("s_waitcnt vmcnt(0)" ::: "memory");
    __syncthreads();
    if (threadIdx.x == 0) {
        unsigned* bar = b.bar;
        __builtin_amdgcn_s_waitcnt(0);
        unsigned nloc = b.st[0], nx = b.st[1];
        if (nloc == 0u) { xcd_barrier_complete(bar, b.x, nloc, nx); b.st[0] = nloc; b.st[1] = nx; }
        const unsigned old = xb_add(&bar[XB_XSUB(b.x)], 1u);
        const unsigned gen = old / nloc;
        if (old + 1u == (gen + 1u) * nloc) {
            __builtin_amdgcn_fence(__ATOMIC_RELEASE, "agent");
            asm volatile("s_waitcnt vmcnt(0)" ::: "memory");
            const unsigned og = xb_add(&bar[XB_TOP], 1u);
            const unsigned tg = og / nx;
            if (og + 1u == (tg + 1u) * nx) xb_add(&bar[XB_TOPGEN], 1u);
            else XB_SPIN(xb_ld(&bar[XB_TOPGEN]) == tg, bar);
            __builtin_amdgcn_fence(__ATOMIC_ACQUIRE, "agent");
            xb_add(&bar[XB_XGEN(b.x)], 1u);
            asm volatile("s_waitcnt vmcnt(0)" ::: "memory");
        } else {
            XB_SPIN(xb_ld(&bar[XB_XGEN(b.x)]) == gen, bar);
            __builtin_amdgcn_fence(__ATOMIC_ACQUIRE, "agent");
            asm volatile("s_waitcnt vmcnt(0)" ::: "memory");
        }
    }
    __syncthreads();
}


struct Frame {
    LAS unsigned char* lds;
    volatile LAS unsigned* MISC;
    int tid, lane, wave;
    int vcu, G;
};
__device__ __forceinline__ Frame phase_frame(const Frame& F0) { Frame F = F0; int t = threadIdx.x; asm volatile("" : "+v"(t)); F.tid = t; F.lane = t & 63; F.wave = __builtin_amdgcn_readfirstlane(t >> 6); return F; }
__device__ __forceinline__ float wave_sum(float v) {
#pragma unroll
    for (int o = 1; o < 64; o <<= 1) v += __shfl_xor(v, o);
    return v;
}

__device__ __forceinline__ void p0_transpose_item(const float* W, int ldw, int src_col, int coloff  , const float* gain, bf16_t* WT, int Kd, int dst_row, int kb, LAS float* scr, int lane) {
    const int k0 = 64 * kb, c = lane & 7;
    f32x4 g0 = {1.f, 1.f, 1.f, 1.f}, g1 = g0;
    if (gain) { g0 = *(const f32x4*)(gain + k0 + 8 * c); g1 = *(const f32x4*)(gain + k0 + 8 * c + 4); }
    float v[32];
#pragma unroll
    for (int i = 0; i < 32; ++i) { const int kk = 2 * i + (lane >> 5); v[i] = W[(size_t)(k0 + kk) * ldw + src_col + coloff]; }
#pragma unroll
    for (int i = 0; i < 32; ++i) { const int kk = 2 * i + (lane >> 5); scr[kk * 33 + (lane & 31)] = v[i]; }
    LDS_WAIT(); asm volatile("" ::: "memory");
#pragma unroll
    for (int j = 0; j < 4; ++j) { const int n = (lane >> 3) + 8 * j; const LAS float* s = scr + (8 * c) * 33 + n;
        v4u o; o.x = pk2(s[0 * 33] * g0.x, s[1 * 33] * g0.y); o.y = pk2(s[2 * 33] * g0.z, s[3 * 33] * g0.w); o.z = pk2(s[4 * 33] * g1.x, s[5 * 33] * g1.y); o.w = pk2(s[6 * 33] * g1.z, s[7 * 33] * g1.w);
        *(GAS v4u*)(WT + (size_t)(dst_row + n) * Kd + k0 + 8 * c) = o; }
    LDS_WAIT(); asm volatile("" ::: "memory");
}
__device__ __forceinline__ void p0_row(const float* xrow, bf16_t* orow, float* ssrow, int lane) {
    const GAS f32x4* xr = (const GAS f32x4*)xrow + lane;
    f32x4 v[4]; float s = 0.f;
#pragma unroll
    for (int j = 0; j < 4; ++j) { v[j] = xr[64 * j]; s += (v[j].x * v[j].x + v[j].y * v[j].y) + (v[j].z * v[j].z + v[j].w * v[j].w); }
    s = wave_sum(s);
    GAS unsigned long long* o8 = (GAS unsigned long long*)orow + lane;
#pragma unroll
    for (int j = 0; j < 4; ++j) o8[64 * j] = (unsigned long long)pk2(v[j].x, v[j].y) | ((unsigned long long)pk2(v[j].z, v[j].w) << 32);
    if (lane == 0) *ssrow = s;
}

constexpr size_t W_L0_QKG = 0, W_L0_V = 6 * cfg::MiB, W_L0_O = 8 * cfg::MiB;
constexpr size_t W_L1_IN = 10 * cfg::MiB, W_L1_UQ = 13 * cfg::MiB, W_L1_UKV = 14 * cfg::MiB, W_L1_O = 15 * cfg::MiB;
constexpr size_t W_L2_QKG = 17 * cfg::MiB, W_L2_V = 21 * cfg::MiB + 512 * 1024, W_L2_O = 22 * cfg::MiB;
constexpr size_t W_L3_QKG = 24 * cfg::MiB, W_L3_V = 30 * cfg::MiB, W_L3_O = 32 * cfg::MiB;
constexpr size_t W_L1_UKA = 36 * cfg::MiB;
constexpr size_t W_L1_UK = 37 * cfg::MiB;

struct Args { const float* in[22]; float* out; unsigned char* ws; int ph_lo, ph_hi, li, pad; };

__device__ __forceinline__ void p0_prologue(const Frame& F, const Args& A) {
    using namespace cfg;
    unsigned char* ws = A.ws;
    LAS float* scr = (LAS float*)(F.lds + RING_OFF + F.wave * 16384);
    const int gw = F.vcu * NWAVES + F.wave, NGW = F.G * NWAVES;
    constexpr int NITEMS = 2 * 2560 + 1568 + 1792 + 64;
    for (int it = gw; it < NITEMS; it += NGW) {
        int r = it; bool found = false;
        const float* W = nullptr; const float* gain = nullptr; bf16_t* dst = nullptr; int ldw = 0, src0 = 0, row0 = 0, Kd = 0, perm = 0, ng = 1;
#define SEG(IN, GAIN, LDW, SRC, NG, DST, ROW0, KK, KD, PERM) { constexpr int n_ = (NG) * ((KK) / 64); \
        if (!found) { if (r < n_) { W = A.in[IN]; gain = ((GAIN) >= 0) ? A.in[(GAIN) < 0 ? 0 : (GAIN)] : nullptr; ldw = (LDW); src0 = (SRC); dst = (bf16_t*)(ws + WS_W + (DST)); row0 = (ROW0); Kd = (KD); perm = (PERM); ng = (NG); found = true; } else r -= n_; } }
        SEG(2, 1, 4096, 0, 64, W_L0_QKG, 0, 1024, 1024, 0)
        SEG(2, 1, 4096, 3072, 32, W_L0_QKG, 2048, 1024, 1024, 0)
        SEG(2, 1, 4096, 2048, 32, W_L0_V, 0, 1024, 1024, 0)
        SEG(3, -1, 1024, 0, 32, W_L0_O, 0, 1024, 1024, 0)
        SEG(5, 4, 1472, 0, 8, W_L1_IN, 0, 1024, 1024, 0)
        SEG(5, 4, 1472, 448, 32, W_L1_IN, 256, 1024, 1024, 0)
        SEG(5, 4, 1472, 256, 4, W_L1_IN, 1280, 1024, 1024, 0)
        SEG(5, 4, 1472, 384, 2, W_L1_IN, 1408, 1024, 1024, 3)
        SEG(7, 6, 1536, 0, 48, W_L1_UQ, 0, 256, 256, 2)
        SEG(9, 8, 2048, 0, 64, W_L1_UKV, 0, 128, 256, 0)
        SEG(9, 8, 2048, 0, 4, W_L1_UK, 0, 128, 256, 0) SEG(9, 8, 2048, 256, 4, W_L1_UK, 128, 128, 256, 0) SEG(9, 8, 2048, 512, 4, W_L1_UK, 256, 128, 256, 0) SEG(9, 8, 2048, 768, 4, W_L1_UK, 384, 128, 256, 0)
        SEG(9, 8, 2048, 1024, 4, W_L1_UK, 512, 128, 256, 0) SEG(9, 8, 2048, 1280, 4, W_L1_UK, 640, 128, 256, 0) SEG(9, 8, 2048, 1536, 4, W_L1_UK, 768, 128, 256, 0) SEG(9, 8, 2048, 1792, 4, W_L1_UK, 896, 128, 256, 0)
        SEG(12, -1, 1024, 0, 32, W_L1_O, 0, 1024, 1024, 0)
        SEG(14, 13, 2560, 0, 32, W_L2_QKG, 0, 1024, 1024, 1)
        SEG(14, 13, 2560, 1024, 8, W_L2_QKG, 1024, 1024, 1024, 1)
        SEG(14, 13, 2560, 1536, 32, W_L2_QKG, 1280, 1024, 1024, 1)
        SEG(14, 13, 2560, 1280, 8, W_L2_V, 0, 1024, 1024, 0)
        SEG(18, -1, 1024, 0, 32, W_L2_O, 0, 1024, 1024, 0)
        SEG(20, 19, 4096, 0, 64, W_L3_QKG, 0, 1024, 1024, 0)
        SEG(20, 19, 4096, 3072, 32, W_L3_QKG, 2048, 1024, 1024, 0)
        SEG(20, 19, 4096, 2048, 32, W_L3_V, 0, 1024, 1024, 0)
        SEG(21, -1, 1024, 0, 32, W_L3_O, 0, 1024, 1024, 0)
#undef SEG
        const int kb = r / ng, gi = r % ng, pg = perm == 1 ? ((gi & ~7) + 4 * (gi & 1) + ((gi & 7) >> 1)) : gi;
        const int j31 = F.lane & 31, il = (j31 >> 1) + 32 * (j31 & 1);
        int sbase = src0 + 32 * gi, coff = j31;
        if (perm == 2) { const int hd = gi / 6, gl = gi % 6; if (gl >= 4) { sbase = src0 + 192 * hd + 128 + 16 * (gl - 4); coff = il; } }
        if (perm == 3) { sbase = src0 + 16 * gi; coff = il; }
        p0_transpose_item(W, ldw, sbase, coff, gain, dst, Kd, row0 + 32 * pg, kb, scr, F.lane);
    }
    { const int gt = gw * 64 + F.lane, NGT = NGW * 64; const v4u z = {0u, 0u, 0u, 0u};
      GAS v4u* p = (GAS v4u*)(ws + WS_W + W_L1_IN + (size_t)1472 * 1024 * 2);
      for (int i = gt; i < 64 * 1024 * 2 / 16; i += NGT) p[i] = z;
      GAS v4u* q = (GAS v4u*)(ws + WS_W + W_L1_UKV);
      for (int i = gt; i < 2048 * 16; i += NGT) q[(size_t)(i >> 4) * 32 + 16 + (i & 15)] = z;
      GAS v4u* q2 = (GAS v4u*)(ws + WS_W + W_L1_UK);
      for (int i = gt; i < 1024 * 16; i += NGT) q2[(size_t)(i >> 4) * 32 + 16 + (i & 15)] = z; }
    { const int gt = gw * 64 + F.lane, NGT = NGW * 64; float* tab = (float*)(ws + WS_ROPE);
      for (int e = gt; e < S * 32; e += NGT) { const int pos = e >> 5, i = e & 31;
          const double inv = exp(-(double)i / 32.0 * 9.210340371976184), rev = (double)pos * inv * 0.15915494309189535, fr = rev - floor(rev);
          const float an = (float)(fr * 6.283185307179586); tab[2 * e] = cosf(an); tab[2 * e + 1] = sinf(an); } }
    if (gw == 0) { float* gp = (float*)(ws + WS_GPERM);
      for (int p = F.lane; p < 192; p += 64) { const int lg = p < 128 ? p : 128 + ((p - 128) >> 1) + 32 * (p & 1); gp[p] = p < 128 ? A.in[10][lg] * A.in[11][lg] : A.in[10][lg]; gp[192 + p] = A.in[11][lg]; } }
    { const int gt = gw * 64 + F.lane, NGT = NGW * 64; bf16_t* wa = (bf16_t*)(ws + WS_W + W_L1_UKA);
      for (int e = gt; e < 8 * 128 * 16; e += NGT) { const int c8 = e & 15, j = (e >> 4) & 127, hh = e >> 11;
          const float* src = A.in[9] + (size_t)j * 2048 + hh * 256 + c8 * 8; const float gj = A.in[8][j];
          const f32x4 a = *(const f32x4*)src, b2 = *(const f32x4*)(src + 4);
          v4u o; o.x = pk2(a.x * gj, a.y * gj); o.y = pk2(a.z * gj, a.w * gj); o.z = pk2(b2.x * gj, b2.y * gj); o.w = pk2(b2.z * gj, b2.w * gj);
          *(GAS v4u*)(wa + ((size_t)(hh * 128 + j) * 128 + c8 * 8)) = o; } }
    { const float* x = A.in[0]; bf16_t* xb = (bf16_t*)(ws + WS_XB); float* ss = (float*)(ws + WS_SS);
      for (int m0 = gw * 4; m0 < M; m0 += NGW * 4) {
          f32x4 v[4][4];
#pragma unroll
          for (int r = 0; r < 4; ++r) { const GAS f32x4* xr = (const GAS f32x4*)(x + (size_t)(m0 + r) * D) + F.lane;
#pragma unroll
              for (int j = 0; j < 4; ++j) v[r][j] = __builtin_nontemporal_load(xr + 64 * j); }
#pragma unroll
          for (int r = 0; r < 4; ++r) { float sq = 0.f;
#pragma unroll
              for (int j = 0; j < 4; ++j) sq += (v[r][j].x * v[r][j].x + v[r][j].y * v[r][j].y) + (v[r][j].z * v[r][j].z + v[r][j].w * v[r][j].w);
              sq = wave_sum(sq);
              GAS unsigned long long* o8 = (GAS unsigned long long*)(xb + (size_t)(m0 + r) * D) + F.lane;
#pragma unroll
              for (int j = 0; j < 4; ++j) o8[64 * j] = (unsigned long long)pk2(v[r][j].x, v[r][j].y) | ((unsigned long long)pk2(v[r][j].z, v[r][j].w) << 32);
              if (F.lane == 0) ss[m0 + r] = sq; } } }
}

__device__ __forceinline__ void mla_prep(const Frame& F, const Args& A) {
    using namespace cfg;
    unsigned char* ws = A.ws;
    const bf16_t* KV2 = (const bf16_t*)(ws + WS_KV2); bf16_t* KR = (bf16_t*)(ws + WS_KR); const float* tab = (const float*)(ws + WS_ROPE); const float* gk = (const float*)(ws + WS_GPERM) + 192 + 128;
    const float* ssn = (const float*)(ws + WS_SSN); float* rk = (float*)(ws + WS_RK);
    const float* sskv = (const float*)(ws + WS_SSKV); bf16_t* KVN = (bf16_t*)(ws + WS_KVN);
    const int gw = F.vcu * NWAVES + F.wave, NGW = F.G * NWAVES, lane = F.lane;
    const float g = gk[lane];
    for (int row0 = gw * 4; row0 < M; row0 += NGW * 4) {
        float kp[4], sn[4];
#pragma unroll
        for (int r = 0; r < 4; ++r) { kp[r] = bf2f(KV2[(size_t)(row0 + r) * 256 + 128 + lane]); sn[r] = 0.f; if (lane < 8) { const f32x4 s4 = *(const f32x4*)(ssn + ((size_t)(row0 + r) * 8 + lane) * 4); sn[r] = (s4.x + s4.y) + (s4.z + s4.w); } }
#pragma unroll
        for (int r = 0; r < 4; ++r) { const int row = row0 + r, pos = row & (S - 1);
            const float sspe = wave_sum(kp[r] * kp[r]);
            if (lane < 8) rk[(size_t)((row >> 12) * 8 + lane) * S + pos] = __builtin_amdgcn_rsqf((sn[r] + sspe) * (1.0f / 192.0f) + NORM_EPS);
            const float x = kp[r] * g, xp = __shfl_xor(x, 1);
            const float cs = tab[(size_t)(pos * 32 + (lane >> 1)) * 2], sn_ = tab[(size_t)(pos * 32 + (lane >> 1)) * 2 + 1];
            const float o = (lane & 1) ? x * cs + xp * sn_ : x * cs - xp * sn_;
            KR[(size_t)row * 64 + lane] = f2bf(o);
        }
        { const int row = row0 + (lane >> 4), c = (lane & 15) * 8;
          const f32x4 s4 = *(const f32x4*)(sskv + (size_t)row * 4); const float rkv = __builtin_amdgcn_rsqf(((s4.x + s4.y) + (s4.z + s4.w)) * (1.0f / 128.0f) + NORM_EPS);
          const v4u w = *(const v4u*)(KV2 + (size_t)row * 256 + c); v4u o4;
          o4.x = pk2(__uint_as_float(w.x << 16) * rkv, __uint_as_float(w.x & 0xffff0000u) * rkv); o4.y = pk2(__uint_as_float(w.y << 16) * rkv, __uint_as_float(w.y & 0xffff0000u) * rkv);
          o4.z = pk2(__uint_as_float(w.z << 16) * rkv, __uint_as_float(w.z & 0xffff0000u) * rkv); o4.w = pk2(__uint_as_float(w.w << 16) * rkv, __uint_as_float(w.w & 0xffff0000u) * rkv);
          *(v4u*)(KVN + (size_t)row * 128 + c) = o4; }
    }
}

namespace att {
typedef short bf16x8 __attribute__((ext_vector_type(8)));
typedef float f32x16 __attribute__((ext_vector_type(16)));
typedef float f32x4 __attribute__((ext_vector_type(4)));
typedef unsigned u32x4 __attribute__((ext_vector_type(4)));
__device__ __forceinline__ unsigned cvtpk(float lo, float hi) { unsigned r; asm volatile("v_cvt_pk_bf16_f32 %0, %1, %2" : "=v"(r) : "v"(lo), "v"(hi)); return r; }
__device__ __forceinline__ int crow(int r, int hi) { return (r & 3) + 8 * (r >> 2) + 4 * hi; }
__device__ __forceinline__ float x32_sum(float x) { const auto rr = __builtin_amdgcn_permlane32_swap(__float_as_uint(x), __float_as_uint(x), false, false); return __uint_as_float(rr[0]) + __uint_as_float(rr[1]); }
__device__ __forceinline__ float x32_max(float x) { const auto rr = __builtin_amdgcn_permlane32_swap(__float_as_uint(x), __float_as_uint(x), false, false); return fmaxf(__uint_as_float(rr[0]), __uint_as_float(rr[1])); }
__device__ __forceinline__ float x32_other(float x, int hi) { const auto rr = __builtin_amdgcn_permlane32_swap(__float_as_uint(x), __float_as_uint(x), false, false); return __uint_as_float(hi ? rr[0] : rr[1]); }
__device__ __forceinline__ float silu(float g) { return g * __builtin_amdgcn_rcpf(1.0f + __builtin_amdgcn_exp2f(-g * cfg::LOG2E)); }

constexpr int STG_ROW = 144, STG_BYTES = 32 * STG_ROW;
typedef unsigned u32x2 __attribute__((ext_vector_type(2)));
__device__ __forceinline__ void stage_gate_in(LAS unsigned char* stg, const bf16_t* Grow0  , int lane_) {
    int lane = lane_; asm volatile("" : "+v"(lane));
#pragma unroll
    for (int i = 0; i < 4; ++i) { const int row = 8 * i + (lane >> 3), ch = lane & 7;
        const u32x4 v = *(const u32x4*)(Grow0 + (size_t)row * 1024 + ch * 8); *(LAS u32x4*)(stg + row * STG_ROW + ch * 16) = v; }
}
__device__ __forceinline__ void stage_gated_out(LAS unsigned char* stg, const f32x16& ot0, const f32x16& ot1, bf16_t* Orow0, int lane_) {
    int lane = lane_; asm volatile("" : "+v"(lane));
    const int q = lane & 31, hi = lane >> 5;
#pragma unroll
    for (int nb = 0; nb < 2; ++nb)
#pragma unroll
        for (int g = 0; g < 4; ++g) { LAS u32x2* p = (LAS u32x2*)(stg + q * STG_ROW + (32 * nb + 8 * g + 4 * hi) * 2);
            const u32x2 gv = *p; const f32x16& o = nb ? ot1 : ot0;
            const float g0 = __uint_as_float(gv.x << 16), g1 = __uint_as_float(gv.x & 0xffff0000u), g2 = __uint_as_float(gv.y << 16), g3 = __uint_as_float(gv.y & 0xffff0000u);
            u32x2 w; w.x = cvtpk(o[4 * g] * silu(g0), o[4 * g + 1] * silu(g1)); w.y = cvtpk(o[4 * g + 2] * silu(g2), o[4 * g + 3] * silu(g3));
            *p = w; }
#pragma unroll
    for (int i = 0; i < 4; ++i) { const int row = 8 * i + (lane >> 3), ch = lane & 7;
        const u32x4 v = *(const LAS u32x4*)(stg + row * STG_ROW + ch * 16); *(u32x4*)(Orow0 + (size_t)row * 1024 + ch * 8) = v; }
}

__device__ __forceinline__ void sb_attn_phase(const Frame& F, const bf16_t* Q, const bf16_t* __restrict__ Kt, const bf16_t* __restrict__ Vtt, const bf16_t* __restrict__ G, bf16_t* OG) {
    using namespace cfg;
    const int lane = F.lane, r32 = lane & 31, hi = lane >> 5;
    for (int idx = F.vcu; idx < B * 16 * 16; idx += F.G) {
        const int bh0 = idx >> 4, b = bh0 >> 4, qb = (idx & 15) ^ (int)((0x96C3A5F0u >> (4 * (b & 7))) & 15u), h = ((bh0 & 15) + b) & 15, bh = b * 16 + h;
        const int t0 = qb * 256 + F.wave * 32;
        bf16x8 qf[4];
        { const bf16_t* Qp = Q + (size_t)(b * S + t0 + r32) * 1024 + h * 64 + hi * 8;
#pragma unroll
          for (int d0 = 0; d0 < 4; ++d0) qf[d0] = *(const bf16x8*)(Qp + d0 * 16); }
        const bf16x8* Kf = (const bf16x8*)Kt + (size_t)bh * (128 * 4 * 64) + lane;
        const bf16x8* Vf = (const bf16x8*)Vtt + (size_t)bh * (128 * 4 * 64) + lane;
        LAS unsigned char* stg = F.lds + RING_OFF + F.wave * STG_BYTES;
        stage_gate_in(stg, G + (size_t)(b * S + t0) * 1024 + h * 64, lane);
        f32x16 o0 = {}, o1 = {};
        float R = 1.0f;
        const int kbd = t0 >> 5;
        bf16x8 ka[4], va[4], kb_[4], vb_[4], kc[4], vc[4], kd[4], vd[4];
#define SB_LOAD(KS, VS, kbx) do { if ((kbx) >= 0) { _Pragma("unroll") for (int i_ = 0; i_ < 4; ++i_) { KS[i_] = Kf[((kbx) * 4 + i_) * 64]; VS[i_] = Vf[((kbx) * 4 + i_) * 64]; } } } while (0)
#define SB_BODY(KS, VS, DIAG) do { \
            f32x16 p = {}; \
            _Pragma("unroll") for (int d0 = 0; d0 < 4; ++d0) p = __builtin_amdgcn_mfma_f32_32x32x16_bf16(KS[d0], qf[d0], p, 0, 0, 0); \
            float w[16]; \
            _Pragma("unroll") for (int r = 0; r < 16; ++r) { float ev = __builtin_amdgcn_exp2f(p[r]); \
                if ((DIAG) && (16 * hi + r >= r32)) ev = 0.f;                         \
                w[r] = __builtin_amdgcn_rcpf(1.0f + ev); } \
            float t2_[8], t4_[4];     \
            _Pragma("unroll") for (int i_ = 0; i_ < 8; ++i_) asm("v_mul_f32 %0, %1, %2" : "=v"(t2_[i_]) : "v"(w[2 * i_]), "v"(w[2 * i_ + 1])); \
            _Pragma("unroll") for (int i_ = 0; i_ < 4; ++i_) asm("v_mul_f32 %0, %1, %2" : "=v"(t4_[i_]) : "v"(t2_[2 * i_]), "v"(t2_[2 * i_ + 1])); \
            const float T = (t4_[0] * t4_[1]) * (t4_[2] * t4_[3]); \
            const float To = x32_other(T, hi); \
            float c = hi == 0 ? R * To : R; \
            float a[16]; \
            _Pragma("unroll") for (int r = 15; r >= 0; --r) { const float cn = c * w[r]; a[r] = c - cn; c = cn; } \
            R = R * (T * To); \
            u32x4 w0, w1; \
            w0.x = cvtpk(a[0], a[1]); w0.y = cvtpk(a[2], a[3]); w0.z = cvtpk(a[4], a[5]); w0.w = cvtpk(a[6], a[7]); \
            w1.x = cvtpk(a[8], a[9]); w1.y = cvtpk(a[10], a[11]); w1.z = cvtpk(a[12], a[13]); w1.w = cvtpk(a[14], a[15]); \
            const bf16x8 pf0 = __builtin_bit_cast(bf16x8, w0), pf1 = __builtin_bit_cast(bf16x8, w1); \
            o0 = __builtin_amdgcn_mfma_f32_32x32x16_bf16(VS[0], pf0, o0, 0, 0, 0);     \
            o0 = __builtin_amdgcn_mfma_f32_32x32x16_bf16(VS[1], pf1, o0, 0, 0, 0); \
            o1 = __builtin_amdgcn_mfma_f32_32x32x16_bf16(VS[2], pf0, o1, 0, 0, 0); \
            o1 = __builtin_amdgcn_mfma_f32_32x32x16_bf16(VS[3], pf1, o1, 0, 0, 0); } while (0)
        SB_LOAD(ka, va, kbd); SB_LOAD(kb_, vb_, kbd - 1); SB_LOAD(kc, vc, kbd - 2); SB_LOAD(kd, vd, kbd - 3);
        for (int kb = kbd; kb >= 0; kb -= 4) {
            SB_BODY(ka, va, kb == kbd); SB_LOAD(ka, va, kb - 4);
            if (kb - 1 < 0 || __all(R == 0.0f)) break;
            SB_BODY(kb_, vb_, false); SB_LOAD(kb_, vb_, kb - 5);
            if (kb - 2 < 0 || __all(R == 0.0f)) break;
            SB_BODY(kc, vc, false); SB_LOAD(kc, vc, kb - 6);
            if (kb - 3 < 0 || __all(R == 0.0f)) break;
            SB_BODY(kd, vd, false); SB_LOAD(kd, vd, kb - 7);
            if (__all(R == 0.0f)) break;
        }
#undef SB_LOAD
#undef SB_BODY
        stage_gated_out(stg, o0, o1, OG + (size_t)(b * S + t0) * 1024 + h * 64, lane);
    }
}

__device__ __forceinline__ void swa_attn_phase(const Frame& F, const bf16_t* Q, const bf16_t* __restrict__ Kt, const bf16_t* __restrict__ Vtt, const bf16_t* __restrict__ G, const float* __restrict__ sinks, bf16_t* OG) {
    using namespace cfg;
    const int lane = F.lane, r32 = lane & 31, hi = lane >> 5;
    for (int idx = F.vcu; idx < B * 4 * 64; idx += F.G) {
        const int b = idx >> 8, kvh = (idx >> 6) & 3, rb = idx & 63;
        const int h = kvh * 4 + (F.wave & 3), t0 = rb * 64 + (F.wave >> 2) * 32;
        const float slope2 = __builtin_amdgcn_exp2f(-0.5f * (float)(h + 1)) * LOG2E, sink2 = sinks[h] * LOG2E;
        bf16x8 qf[4];
        { const bf16_t* Qp = Q + (size_t)(b * S + t0 + r32) * 1024 + h * 64 + hi * 8;
#pragma unroll
          for (int d0 = 0; d0 < 4; ++d0) qf[d0] = *(const bf16x8*)(Qp + d0 * 16); }
        LAS unsigned char* stg = F.lds + RING_OFF + F.wave * STG_BYTES;
        stage_gate_in(stg, G + (size_t)(b * S + t0) * 1024 + h * 64, lane);
        const int kb0 = (t0 >> 5) - 4;
        const bf16x8* Kf = (const bf16x8*)Kt + (size_t)(b * 4 + kvh) * (128 * 4 * 64) + lane;
        const bf16x8* Vf = (const bf16x8*)Vtt + (size_t)(b * 4 + kvh) * (128 * 4 * 64) + lane;
        bf16x8 kf[5][4];
#pragma unroll
        for (int i = 0; i < 5; ++i) { const int kbi = kb0 + i < 0 ? 0 : kb0 + i;
#pragma unroll
            for (int d0 = 0; d0 < 4; ++d0) kf[i][d0] = Kf[(kbi * 4 + d0) * 64]; }
        f32x16 p[5];
#pragma unroll
        for (int i = 0; i < 5; ++i) { f32x16 acc = {};
#pragma unroll
            for (int d0 = 0; d0 < 4; ++d0) acc = __builtin_amdgcn_mfma_f32_32x32x16_bf16(kf[i][d0], qf[d0], acc, 0, 0, 0);
            p[i] = acc; }
        __builtin_amdgcn_sched_barrier(0);
        bf16x8 vf[5][4];
#pragma unroll
        for (int i = 0; i < 5; ++i) { const int kbi = kb0 + i < 0 ? 0 : kb0 + i;
#pragma unroll
            for (int f = 0; f < 4; ++f) vf[i][f] = Vf[(kbi * 4 + f) * 64]; }
        __builtin_amdgcn_sched_barrier(0);
        int rl = r32 - 16 * hi; asm volatile("" : "+v"(rl));
        const float srl = slope2 * (float)rl;
        float mx = sink2, mxb = -INFINITY;
#pragma unroll
        for (int i = 0; i < 5; ++i) { const bool exists = kb0 + i >= 0;
            const float ci = exists ? fmaf(slope2, (float)(128 - 32 * i), srl) : INFINITY;
#pragma unroll
            for (int r = 0; r < 16; ++r) { float v = (p[i][r] + slope2 * (float)r) - ci;
                if (i == 0) { if (r <= rl) v = -INFINITY; }
                if (i == 4) { if (r > rl) v = -INFINITY; }
                p[i][r] = v; }
#pragma unroll
            for (int r = 0; r < 16; r += 4) { asm("v_max3_f32 %0, %1, %2, %3" : "=v"(mx) : "v"(mx), "v"(p[i][r]), "v"(p[i][r + 1])); asm("v_max3_f32 %0, %1, %2, %3" : "=v"(mxb) : "v"(mxb), "v"(p[i][r + 2]), "v"(p[i][r + 3])); } }
        asm("v_max_f32 %0, %1, %2" : "=v"(mx) : "v"(mx), "v"(mxb));
        { const float mo = x32_other(mx, hi); asm("v_max_f32 %0, %1, %2" : "=v"(mx) : "v"(mx), "v"(mo)); }
        float sum = 0.f;
#pragma unroll
        for (int i = 0; i < 5; ++i)
#pragma unroll
            for (int r = 0; r < 16; ++r) { const float ev = __builtin_amdgcn_exp2f(p[i][r] - mx); p[i][r] = ev; sum += ev; }
        sum = x32_sum(sum);
        const float inv = __builtin_amdgcn_rcpf(sum + __builtin_amdgcn_exp2f(sink2 - mx));
        f32x16 o0 = {}, o1 = {};
#pragma unroll
        for (int i = 0; i < 5; ++i) { u32x4 w0, w1;
            w0.x = cvtpk(p[i][0], p[i][1]); w0.y = cvtpk(p[i][2], p[i][3]); w0.z = cvtpk(p[i][4], p[i][5]); w0.w = cvtpk(p[i][6], p[i][7]);
            w1.x = cvtpk(p[i][8], p[i][9]); w1.y = cvtpk(p[i][10], p[i][11]); w1.z = cvtpk(p[i][12], p[i][13]); w1.w = cvtpk(p[i][14], p[i][15]);
            const bf16x8 pf0 = __builtin_bit_cast(bf16x8, w0), pf1 = __builtin_bit_cast(bf16x8, w1);
            o0 = __builtin_amdgcn_mfma_f32_32x32x16_bf16(vf[i][0], pf0, o0, 0, 0, 0);
            o0 = __builtin_amdgcn_mfma_f32_32x32x16_bf16(vf[i][1], pf1, o0, 0, 0, 0);
            o1 = __builtin_amdgcn_mfma_f32_32x32x16_bf16(vf[i][2], pf0, o1, 0, 0, 0);
            o1 = __builtin_amdgcn_mfma_f32_32x32x16_bf16(vf[i][3], pf1, o1, 0, 0, 0); }
#pragma unroll
        for (int r = 0; r < 16; ++r) { o0[r] *= inv; o1[r] *= inv; }
        stage_gated_out(stg, o0, o1, OG + (size_t)(b * S + t0) * 1024 + h * 64, lane);
    }
}

constexpr int MLA_RK = 160768;
constexpr int MLA_KB = 24576, MLA_VB = 16384, MLA_V0 = 0, MLA_K0 = 3 * MLA_VB, MLA_WS = MLA_K0 + 3 * MLA_KB;
typedef short v4i16_t __attribute__((ext_vector_type(4)));
__device__ __forceinline__ v4i16_t vtr(const LAS unsigned char* p) { return __builtin_amdgcn_ds_read_tr16_b64_v4i16((LAS v4i16_t*)p); }
__device__ __forceinline__ int swap23(int k) { return (k & ~0xC) | ((k & 4) << 1) | ((k & 8) >> 1); }
#define MLA_BAR() asm volatile("s_waitcnt vmcnt(0) lgkmcnt(0)\n\ts_barrier" ::: "memory")
#define SBAR() __builtin_amdgcn_sched_barrier(0)

__device__ __forceinline__ void mla_attn_phase(const Frame& F, const bf16_t* __restrict__ Qm, const bf16_t* Gin, bf16_t* Gout, const unsigned char* ws_) {
    using namespace cfg;
    const int lane = F.lane, r32 = lane & 31, hi = lane >> 5, wave = F.wave;
    const bool halfB = wave >= 4;
    LAS unsigned char* lds = F.lds + RING_OFF;
    const int nun = 2 * ((512 - F.vcu + F.G - 1) / F.G);
#define MLA_COORDS(k_, b_, h_, qb_) const int it_##b_ = F.vcu + ((k_) >> 1) * F.G, b_ = it_##b_ >> 6, h_ = (it_##b_ >> 3) & 7, qb_ = ((k_) & 1) ? (it_##b_ & 7) : 15 - (it_##b_ & 7)
    const __amdgpu_buffer_rsrc_t rW = __builtin_amdgcn_make_buffer_rsrc((void*)ws_, 0, 0x7ffffff0, 0x00020000);
    unsigned koffN, koffP, voff, rbase;
#define MLA_OFFS(b_, h_) do { { const int row = 8 * wave + (lane >> 3), c = (lane & 7) ^ ((row >> 1) & 7); \
      koffN = (unsigned)WS_KVN + (unsigned)(((b_) * S + row) * 128 + c * 8) * 2u; koffP = (unsigned)WS_KR + (unsigned)(((b_) * S + row) * 64 + c * 8) * 2u; } \
    { const int kk = (wave << 3) | ((lane >> 2) & 7), c8 = ((lane >> 5) << 2) | (lane & 3); voff = (unsigned)WS_KVN + (unsigned)(((b_) * S + swap23(kk)) * 128 + c8 * 8) * 2u; }     \
    rbase = (unsigned)WS_RK + (unsigned)(((b_) * 8 + (h_)) * S) * 4u; } while (0)
#define MLA_DMA_K1(t_, buf_, i) __builtin_amdgcn_raw_ptr_buffer_load_lds(rW, (LAS void*)(lds + MLA_K0 + (buf_) * MLA_KB + (i) * 8192 + wave * 1024), 16, (i) == 2 ? koffP : koffN, \
        (i) == 2 ? (t_) * (64 * 64 * 2) : (t_) * (64 * 128 * 2) + (i) * 128, 0, 0)
#define MLA_DMA_R(t_, buf_) do { unsigned rv_ = lane; asm volatile("" : "+v"(rv_)); __builtin_amdgcn_raw_ptr_buffer_load_lds(rW, (LAS void*)(lds + MLA_RK + ((t_) & 3) * 256), 4, rv_ * 4u, rbase + (t_) * 256, 0, 0); } while (0)
#define MLA_DMA_V1(t_, buf_, i) __builtin_amdgcn_raw_ptr_buffer_load_lds(rW, (LAS void*)(lds + MLA_V0 + (buf_) * MLA_VB + (wave * 2 + (i)) * 1024), 16, voff, (t_) * (64 * 128 * 2) + (i) * 128, 0, 0)
#define MLA_DMA_K(t_, buf_) do { _Pragma("unroll") for (int i = 0; i < 3; ++i) MLA_DMA_K1(t_, buf_, i); MLA_DMA_R(t_, buf_); } while (0)
#define MLA_DMA_V(t_, buf_) do { _Pragma("unroll") for (int i = 0; i < 2; ++i) MLA_DMA_V1(t_, buf_, i); } while (0)
#define MLA_REQUEST(b_, h_, qb_) do { MLA_OFFS(b_, h_); \
      MLA_DMA_K(0, 0); MLA_DMA_V(0, 0); MLA_DMA_K(1, 1); if (halfB) { MLA_DMA_V(1, 1); }     \
      { unsigned lv_ = lane; asm volatile("" : "+v"(lv_));     \
        const unsigned wao = (unsigned)(WS_W + W_L1_UKA) + (unsigned)(((h_) * 128 + (int)(lv_ & 31u)) * 128 + (int)(lv_ >> 5) * 8) * 2u; \
        _Pragma("unroll") for (int i = 0; i < 4; ++i) __builtin_amdgcn_raw_ptr_buffer_load_lds(rW, (LAS void*)(lds + (wave < 4 ? MLA_V0 + 2 * MLA_VB + (wave * 4 + i) * 1024 : MLA_K0 + 2 * MLA_KB + ((wave - 4) * 4 + i) * 1024)), 16, wao, ((wave >> 1) * (32 * 128) + (4 * (wave & 1) + i) * 16) * 2, 0, 0); } \
      (void)(qb_); } while (0)
#define MLA_WQ_DMA(h_) do { unsigned lv_ = lane; asm volatile("" : "+v"(lv_)); \
      const unsigned wqo = (unsigned)(WS_W + W_L1_UQ) + (unsigned)(((h_) * 192 + (int)(lv_ & 31u)) * 256 + (int)(lv_ >> 5) * 8) * 2u; \
      _Pragma("unroll") for (int i = 0; i < 12; ++i) { const int p_ = wave * 12 + i; \
          __builtin_amdgcn_raw_ptr_buffer_load_lds(rW, (LAS void*)(lds + p_ * 1024), 16, wqo, ((p_ >> 4) * (32 * 256) + (p_ & 15) * 16) * 2, 0, 0); } } while (0)
#define MLA_UQ_LOAD(b_, h_, qb_) do { (void)(h_); \
      const bf16_t* Qlp = (const bf16_t*)(ws_ + WS_QL) + (size_t)((b_) * S + (qb_) * 256 + wave * 32 + r32) * 256 + hi * 8; \
      _Pragma("unroll") for (int ks = 0; ks < 16; ++ks) Bq[ks] = *(const bf16x8*)(Qlp + ks * 16); \
      s4q = *(const f32x4*)((const float*)(ws_ + WS_SSQ) + (size_t)((b_) * S + (qb_) * 256 + wave * 32 + r32) * 4); } while (0)
#define MLA_UQ(b_, h_, qb_, vm_) do { const f32x4 s4 = s4q; \
      asm volatile("s_waitcnt vmcnt(" #vm_ ") lgkmcnt(0)\n\ts_barrier" ::: "memory");     \
      const float rq = __builtin_amdgcn_rsqf(((s4.x + s4.y) + (s4.z + s4.w)) * (1.0f / 256.0f) + NORM_EPS); \
      f32x16 qa[6] = {}; bf16x8 Af[2][6]; int lf_ = lane; asm volatile("" : "+v"(lf_)); \
      _Pragma("unroll") for (int db = 0; db < 6; ++db) Af[0][db] = *(const LAS bf16x8*)(lds + (db * 16) * 1024 + lf_ * 16); \
      _Pragma("unroll") for (int ks = 0; ks < 16; ++ks) { SBAR(); \
          if (ks + 1 < 16) { _Pragma("unroll") for (int db = 0; db < 6; ++db) Af[(ks + 1) & 1][db] = *(const LAS bf16x8*)(lds + (db * 16 + ks + 1) * 1024 + lf_ * 16); } \
          _Pragma("unroll") for (int db = 0; db < 6; ++db) qa[db] = __builtin_amdgcn_mfma_f32_32x32x16_bf16(Af[ks & 1][db], Bq[ks], qa[db], 0, 0, 0); } \
      asm volatile("s_waitcnt lgkmcnt(0)\n\ts_barrier" ::: "memory");     \
      MLA_REQUEST(b_, h_, qb_); \
      _Pragma("unroll") for (int db = 0; db < 6; ++db) _Pragma("unroll") for (int g = 0; g < 2; ++g) { \
          const unsigned u0 = cvtpk(qa[db][8 * g + 0] * rq, qa[db][8 * g + 1] * rq), u1 = cvtpk(qa[db][8 * g + 2] * rq, qa[db][8 * g + 3] * rq); \
          const unsigned v0 = cvtpk(qa[db][8 * g + 4] * rq, qa[db][8 * g + 5] * rq), v1 = cvtpk(qa[db][8 * g + 6] * rq, qa[db][8 * g + 7] * rq); \
          const auto e0 = __builtin_amdgcn_permlane32_swap(u0, v0, false, false), e1 = __builtin_amdgcn_permlane32_swap(u1, v1, false, false); \
          u32x4 w; w.x = e0[0]; w.y = e1[0]; w.z = e0[1]; w.w = e1[1]; qf[2 * db + g] = __builtin_bit_cast(bf16x8, w); } } while (0)
    bf16x8 qf[12];
    bf16x8 Bq[16]; f32x4 s4q;
    MLA_BAR();
    { MLA_COORDS(0, b0_, h0_, q0_); MLA_WQ_DMA(h0_); MLA_UQ_LOAD(b0_, h0_, q0_); MLA_UQ(b0_, h0_, q0_, 0); }
    for (int k = 0; k < nun; ++k) {
    MLA_COORDS(k, b, h, qb);
    const int t0 = qb * 256 + wave * 32, NT = 4 * (qb + 1);
    { float ssq = 0.f;
#pragma unroll
      for (int d0 = 0; d0 < 12; ++d0)
#pragma unroll
          for (int j = 0; j < 8; ++j) { const float v = bf2f((bf16_t)qf[d0][j]); ssq = fmaf(v, v, ssq); }
      ssq = x32_sum(ssq);
      const float rh = __builtin_amdgcn_rsqf(ssq * (1.0f / 192.0f) + NORM_EPS) * MLA_QSCALE;
      int hio = hi; asm volatile("" : "+v"(hio));
      const float* gq = (const float*)(ws_ + WS_GPERM) + 8 * hio; const float* tb = (const float*)(ws_ + WS_ROPE) + (size_t)((t0 + r32) * 32 + 4 * hio) * 2;
#pragma unroll
      for (int d0 = 0; d0 < 12; ++d0) { const f32x4 ga = *(const f32x4*)(gq + 16 * d0), gb = *(const f32x4*)(gq + 16 * d0 + 4);
          f32x4 a = {bf2f((bf16_t)qf[d0][0]), bf2f((bf16_t)qf[d0][1]), bf2f((bf16_t)qf[d0][2]), bf2f((bf16_t)qf[d0][3])};
          f32x4 c = {bf2f((bf16_t)qf[d0][4]), bf2f((bf16_t)qf[d0][5]), bf2f((bf16_t)qf[d0][6]), bf2f((bf16_t)qf[d0][7])};
          a = a * rh * ga; c = c * rh * gb;
          if (d0 >= 8) { const f32x4 cs0 = *(const f32x4*)(tb + 16 * (d0 - 8)), cs1 = *(const f32x4*)(tb + 16 * (d0 - 8) + 4);
              const f32x4 ar = {a.x * cs0.x - a.y * cs0.y, a.y * cs0.x + a.x * cs0.y, a.z * cs0.z - a.w * cs0.w, a.w * cs0.z + a.z * cs0.w};
              const f32x4 cr = {c.x * cs1.x - c.y * cs1.y, c.y * cs1.x + c.x * cs1.y, c.z * cs1.z - c.w * cs1.w, c.w * cs1.z + c.z * cs1.w}; a = ar; c = cr; }
          u32x4 w; w.x = cvtpk(a.x, a.y); w.y = cvtpk(a.z, a.w); w.z = cvtpk(c.x, c.y); w.w = cvtpk(c.z, c.w); qf[d0] = __builtin_bit_cast(bf16x8, w); } }
    MLA_BAR();
    { f32x16 qa[4] = {};
      bf16x8 Aq[2][8];
      int lf_ = lane; asm volatile("" : "+v"(lf_));
#define UA_LD(hf_) do { _Pragma("unroll") for (int nl = 0; nl < 2; ++nl) _Pragma("unroll") for (int cs = 0; cs < 8; ++cs) \
        Aq[nl][cs] = *(const LAS bf16x8*)(lds + ((hf_) == 0 ? MLA_V0 + 2 * MLA_VB : MLA_K0 + 2 * MLA_KB) + (nl * 8 + cs) * 1024 + lf_ * 16); } while (0)
#define UA_MM(hf_) do { _Pragma("unroll") for (int nl = 0; nl < 2; ++nl) _Pragma("unroll") for (int cs = 0; cs < 8; ++cs) qa[2 * (hf_) + nl] = __builtin_amdgcn_mfma_f32_32x32x16_bf16(Aq[nl][cs], qf[cs], qa[2 * (hf_) + nl], 0, 0, 0); } while (0)
      UA_LD(0); SBAR(); UA_MM(0); SBAR(); UA_LD(1); SBAR(); UA_MM(1); SBAR();
#undef UA_LD
#undef UA_MM
#pragma unroll
      for (int jb = 0; jb < 4; ++jb)
#pragma unroll
          for (int g = 0; g < 2; ++g) {
              const unsigned u0 = cvtpk(qa[jb][8 * g + 0], qa[jb][8 * g + 1]), u1 = cvtpk(qa[jb][8 * g + 2], qa[jb][8 * g + 3]);
              const unsigned v0 = cvtpk(qa[jb][8 * g + 4], qa[jb][8 * g + 5]), v1 = cvtpk(qa[jb][8 * g + 6], qa[jb][8 * g + 7]);
              const auto e0 = __builtin_amdgcn_permlane32_swap(u0, v0, false, false), e1 = __builtin_amdgcn_permlane32_swap(u1, v1, false, false);
              u32x4 w; w.x = e0[0]; w.y = e1[0]; w.z = e0[1]; w.w = e1[1]; qf[2 * jb + g] = __builtin_bit_cast(bf16x8, w); } }
    asm volatile("s_waitcnt lgkmcnt(0)\n\ts_barrier" ::: "memory");
    if (halfB) MLA_DMA_K(2, 2);
    const int krow = swap23(r32), kx = (krow >> 1) & 7;
    int kad[4];
#pragma unroll
    for (int j = 0; j < 4; ++j) kad[j] = MLA_K0 + krow * 128 + 16 * ((2 * j + hi) ^ kx);
    const int vb0 = MLA_V0 + (((lane & 3) << 3) | (((lane >> 2) & 3) << 6) | (((lane >> 4) & 1) << 5) | (((lane >> 5) & 1) << 8));
    f32x16 o[4] = {};
    float mhat = 0.f, l = 0.f;
    f32x16 p0, p1;
    bf16x8 ka[4], kc[4];
#define MLA_KRD(dst, g_, kbo_) do { _Pragma("unroll") for (int j_ = 0; j_ < 2; ++j_) { const int d0_ = 2 * (g_) + j_; const LAS unsigned char* a_ = lds + (kbo_) + kad[d0_ & 3] + 8192 * (d0_ >> 2); \
        dst[2 * j_] = *(const LAS bf16x8*)a_; dst[2 * j_ + 1] = *(const LAS bf16x8*)(a_ + 32 * 128); } } while (0)
#define MLA_KMM(src, g_) do { _Pragma("unroll") for (int j_ = 0; j_ < 2; ++j_) { \
        p0 = __builtin_amdgcn_mfma_f32_32x32x16_bf16(src[2 * j_], qf[2 * (g_) + j_], ((g_) == 0 && j_ == 0) ? (f32x16){} : p0, 0, 0, 0); \
        p1 = __builtin_amdgcn_mfma_f32_32x32x16_bf16(src[2 * j_ + 1], qf[2 * (g_) + j_], ((g_) == 0 && j_ == 0) ? (f32x16){} : p1, 0, 0, 0); } } while (0)
#define MLA_QK(kbo_, rs_) do { SBAR(); MLA_KRD(ka, 0, kbo_); MLA_KRD(kc, 1, kbo_); SBAR(); MLA_KMM(ka, 0); SBAR(); MLA_KRD(ka, 2, kbo_); SBAR(); MLA_KMM(kc, 1); SBAR(); MLA_KRD(kc, 3, kbo_); SBAR(); \
        MLA_KMM(ka, 2); SBAR(); MLA_KRD(ka, 4, kbo_); SBAR(); MLA_KMM(kc, 3); SBAR(); MLA_KRD(kc, 5, kbo_); SBAR(); MLA_KMM(ka, 4); SBAR(); MLA_KMM(kc, 5); SBAR(); } while (0)
    { unsigned lv_ = lane; asm volatile("" : "+v"(lv_));
      const unsigned wvo = (unsigned)(WS_W + W_L1_UKV) + (unsigned)((h * 256 + 128 + (int)(lv_ & 31u)) * 256 + (int)(lv_ >> 5) * 8) * 2u;
#pragma unroll
      for (int i = 0; i < 4; ++i) __builtin_amdgcn_raw_ptr_buffer_load_lds(rW, (LAS void*)(lds + MLA_WS + (wave * 4 + i) * 1024), 16, wvo, ((wave >> 1) * (32 * 256) + (4 * (wave & 1) + i) * 16) * 2, 0, 0); }
    MLA_QK(0, 0);
    if (halfB) asm volatile("s_waitcnt lgkmcnt(0)\n\ts_barrier" ::: "memory");
    bf16x8 pa[4];
    int s0 = 0, s1 = 1, s2 = 2;
    const int nact = (t0 + 31) / 64 + 1;
    int t = 0;
    for (; t < nact; ++t) {
        { const int tk = min(t + 2 + (int)halfB, NT - 1), tv = min(t + 1 + (int)halfB, NT - 1), sk = halfB ? s0 : s2, sv = halfB ? s2 : s1;
          MLA_DMA_K1(tk, sk, 0); MLA_DMA_K1(tk, sk, 1); MLA_DMA_K1(tk, sk, 2); MLA_DMA_R(tk, sk); MLA_DMA_V1(tv, sv, 0); MLA_DMA_V1(tv, sv, 1); }
        {
            { const LAS float* rl_ = (const LAS float*)(lds + MLA_RK + (t & 3) * 256) + 8 * hi;
#pragma unroll
              for (int j_ = 0; j_ < 2; ++j_) { const f32x4 a_ = *(const LAS f32x4*)(rl_ + 16 * j_), b_ = *(const LAS f32x4*)(rl_ + 16 * j_ + 4), c_ = *(const LAS f32x4*)(rl_ + 32 + 16 * j_), d_ = *(const LAS f32x4*)(rl_ + 32 + 16 * j_ + 4);
#pragma unroll
                  for (int e_ = 0; e_ < 4; ++e_) {
                      asm("v_fma_f32 %0, %1, %2, -%3" : "=v"(p0[8 * j_ + e_]) : "v"(p0[8 * j_ + e_]), "v"(a_[e_]), "v"(mhat)); asm("v_fma_f32 %0, %1, %2, -%3" : "=v"(p0[8 * j_ + 4 + e_]) : "v"(p0[8 * j_ + 4 + e_]), "v"(b_[e_]), "v"(mhat));
                      asm("v_fma_f32 %0, %1, %2, -%3" : "=v"(p1[8 * j_ + e_]) : "v"(p1[8 * j_ + e_]), "v"(c_[e_]), "v"(mhat)); asm("v_fma_f32 %0, %1, %2, -%3" : "=v"(p1[8 * j_ + 4 + e_]) : "v"(p1[8 * j_ + 4 + e_]), "v"(d_[e_]), "v"(mhat)); } } }
            if (64 * t + 63 > t0) {
                const int lim = t0 + r32 - 64 * t - 8 * hi;
#pragma unroll
                for (int r = 0; r < 16; ++r) { const int ko = 16 * (r >> 3) + (r & 7); if (ko > lim) p0[r] = -INFINITY; if (ko + 32 > lim) p1[r] = -INFINITY; } }
            float pmax, pmb;
            asm("v_max3_f32 %0, %1, %2, %3" : "=v"(pmax) : "v"(p0[0]), "v"(p0[1]), "v"(p0[2])); asm("v_max3_f32 %0, %1, %2, %3" : "=v"(pmb) : "v"(p1[0]), "v"(p1[1]), "v"(p1[2]));
#pragma unroll
            for (int r = 3; r < 15; r += 2) { asm("v_max3_f32 %0, %1, %2, %3" : "=v"(pmax) : "v"(pmax), "v"(p0[r]), "v"(p0[r + 1])); asm("v_max3_f32 %0, %1, %2, %3" : "=v"(pmb) : "v"(pmb), "v"(p1[r]), "v"(p1[r + 1])); }
            asm("v_max3_f32 %0, %1, %2, %3" : "=v"(pmax) : "v"(pmax), "v"(p0[15]), "v"(p1[15])); asm("v_max_f32 %0, %1, %2" : "=v"(pmax) : "v"(pmax), "v"(pmb));
            { const float po = x32_other(pmax, hi); asm("v_max_f32 %0, %1, %2" : "=v"(pmax) : "v"(pmax), "v"(po)); }
            if (t == 0 || __any(pmax > 8.0f)) {
                const float d = t == 0 ? pmax : fmaxf(pmax, 0.f);
                if (t != 0) { const float f = __builtin_amdgcn_exp2f(-d); l *= f;
#pragma unroll
                    for (int nb = 0; nb < 4; ++nb)
#pragma unroll
                        for (int r = 0; r < 16; ++r) o[nb][r] *= f; }
                mhat += d;
#pragma unroll
                for (int r = 0; r < 16; ++r) { p0[r] -= d; p1[r] -= d; }
            }
            float ps = 0.f;
#pragma unroll
            for (int r = 0; r < 16; ++r) { p0[r] = __builtin_amdgcn_exp2f(p0[r]); p1[r] = __builtin_amdgcn_exp2f(p1[r]); ps += p0[r] + p1[r]; }
            l += ps; asm volatile("" : "+v"(l));
            u32x4 w;
            w.x = cvtpk(p0[0], p0[1]); w.y = cvtpk(p0[2], p0[3]); w.z = cvtpk(p0[4], p0[5]); w.w = cvtpk(p0[6], p0[7]); pa[0] = __builtin_bit_cast(bf16x8, w);
            w.x = cvtpk(p0[8], p0[9]); w.y = cvtpk(p0[10], p0[11]); w.z = cvtpk(p0[12], p0[13]); w.w = cvtpk(p0[14], p0[15]); pa[1] = __builtin_bit_cast(bf16x8, w);
            w.x = cvtpk(p1[0], p1[1]); w.y = cvtpk(p1[2], p1[3]); w.z = cvtpk(p1[4], p1[5]); w.w = cvtpk(p1[6], p1[7]); pa[2] = __builtin_bit_cast(bf16x8, w);
            w.x = cvtpk(p1[8], p1[9]); w.y = cvtpk(p1[10], p1[11]); w.z = cvtpk(p1[12], p1[13]); w.w = cvtpk(p1[14], p1[15]); pa[3] = __builtin_bit_cast(bf16x8, w);
        }
        if (halfB) asm volatile("s_waitcnt lgkmcnt(0)\n\ts_barrier" ::: "memory");
        else asm volatile("s_waitcnt vmcnt(6) lgkmcnt(0)\n\ts_barrier" ::: "memory");
        __builtin_amdgcn_s_setprio(1);
        {
            const int vbo = s0 * MLA_VB;
            bf16x8 va[4], vc[4];
#define MLA_VRD(dst, nb_) do { const LAS unsigned char* vp_ = lds + vbo + vb0 + (nb_) * 512; _Pragma("unroll") for (int ks = 0; ks < 4; ++ks) { const v4i16_t lo_ = vtr(vp_ + ks * 4096), hh_ = vtr(vp_ + ks * 4096 + 2048); \
                dst[ks] = (bf16x8){lo_[0], lo_[1], lo_[2], lo_[3], hh_[0], hh_[1], hh_[2], hh_[3]}; } } while (0)
#define MLA_VMM(src, nb_) do { _Pragma("unroll") for (int ks = 0; ks < 4; ++ks) o[nb_] = __builtin_amdgcn_mfma_f32_32x32x16_bf16(src[ks], pa[ks], o[nb_], 0, 0, 0); } while (0)
            SBAR(); MLA_VRD(va, 0); MLA_VRD(vc, 1); SBAR();
            MLA_VMM(va, 0); SBAR(); MLA_VRD(va, 2); SBAR();
            MLA_VMM(vc, 1); SBAR(); MLA_VRD(vc, 3); SBAR();
            MLA_VMM(va, 2); SBAR();
            MLA_VMM(vc, 3); SBAR();
#undef MLA_VRD
#undef MLA_VMM
        }
        { const int kbo = s1 * MLA_KB;
            SBAR(); MLA_KRD(ka, 0, kbo); MLA_KRD(kc, 1, kbo); SBAR(); MLA_KMM(ka, 0); SBAR(); MLA_KRD(ka, 2, kbo); SBAR(); MLA_KMM(kc, 1); SBAR(); MLA_KRD(kc, 3, kbo); SBAR();
            MLA_KMM(ka, 2); SBAR(); MLA_KRD(ka, 4, kbo); SBAR(); MLA_KMM(kc, 3); SBAR(); MLA_KRD(kc, 5, kbo); SBAR(); MLA_KMM(ka, 4); SBAR(); MLA_KMM(kc, 5); SBAR(); }
        __builtin_amdgcn_s_setprio(0);
        if (halfB && t == NT - 1) asm volatile("s_waitcnt vmcnt(0)" ::: "memory");
        if (!halfB) asm volatile("s_waitcnt lgkmcnt(0)\n\ts_barrier" ::: "memory");
        else asm volatile("s_waitcnt vmcnt(6) lgkmcnt(0)\n\ts_barrier" ::: "memory");
        { const int tmp = s0; s0 = s1; s1 = s2; s2 = tmp; }
    }
    for (; t < NT; ++t) {
        { const int tk = min(t + 2 + (int)halfB, NT - 1), tv = min(t + 1 + (int)halfB, NT - 1), sk = halfB ? s0 : s2, sv = halfB ? s2 : s1;
          MLA_DMA_K1(tk, sk, 0); MLA_DMA_K1(tk, sk, 1); MLA_DMA_K1(tk, sk, 2); MLA_DMA_R(tk, sk); MLA_DMA_V1(tv, sv, 0); MLA_DMA_V1(tv, sv, 1); }
        if (halfB) asm volatile("s_waitcnt lgkmcnt(0)\n\ts_barrier" ::: "memory");
        else asm volatile("s_waitcnt vmcnt(6) lgkmcnt(0)\n\ts_barrier" ::: "memory");
        if (halfB && t == NT - 1) asm volatile("s_waitcnt vmcnt(0)" ::: "memory");
        if (!halfB) asm volatile("s_waitcnt lgkmcnt(0)\n\ts_barrier" ::: "memory");
        else asm volatile("s_waitcnt vmcnt(6) lgkmcnt(0)\n\ts_barrier" ::: "memory");
        { const int tmp = s0; s0 = s1; s1 = s2; s2 = tmp; }
    }
    if (!halfB) MLA_BAR();
    if (k + 1 < nun) { MLA_COORDS(k + 1, bw_, hw_, qw_); (void)bw_; (void)qw_; MLA_WQ_DMA(hw_); }
#undef MLA_KRD
#undef MLA_KMM
#undef MLA_QK
    l = x32_sum(l);
    const float il = __builtin_amdgcn_rcpf(l);
    LAS unsigned char* stg = lds + MLA_WS + wave * STG_BYTES;
    const size_t go = (size_t)(b * S + t0) * 1024 + h * 128;
    bf16x8 Bo[8];
#pragma unroll
    for (int nb = 0; nb < 4; ++nb)
#pragma unroll
        for (int g = 0; g < 2; ++g) {
            const unsigned u0 = cvtpk(o[nb][8 * g + 0] * il, o[nb][8 * g + 1] * il), u1 = cvtpk(o[nb][8 * g + 2] * il, o[nb][8 * g + 3] * il);
            const unsigned v0 = cvtpk(o[nb][8 * g + 4] * il, o[nb][8 * g + 5] * il), v1 = cvtpk(o[nb][8 * g + 6] * il, o[nb][8 * g + 7] * il);
            const auto e0 = __builtin_amdgcn_permlane32_swap(u0, v0, false, false), e1 = __builtin_amdgcn_permlane32_swap(u1, v1, false, false);
            u32x4 w; w.x = e0[0]; w.y = e1[0]; w.z = e0[1]; w.w = e1[1]; Bo[2 * nb + g] = __builtin_bit_cast(bf16x8, w); }
    u32x4 gv[2][4];
    f32x16 o2[4] = {};
    { bf16x8 Aw[2][8];
      int lf_ = lane; asm volatile("" : "+v"(lf_));
#define UV_LD(hf_) do { _Pragma("unroll") for (int nl = 0; nl < 2; ++nl) _Pragma("unroll") for (int ks = 0; ks < 8; ++ks) Aw[nl][ks] = *(const LAS bf16x8*)(lds + MLA_WS + ((2 * (hf_) + nl) * 8 + ks) * 1024 + lf_ * 16); } while (0)
#define UV_MM(hf_) do { _Pragma("unroll") for (int nl = 0; nl < 2; ++nl) _Pragma("unroll") for (int ks = 0; ks < 8; ++ks) o2[2 * (hf_) + nl] = __builtin_amdgcn_mfma_f32_32x32x16_bf16(Aw[nl][ks], Bo[ks], o2[2 * (hf_) + nl], 0, 0, 0); } while (0)
#define UV_GATE(hf_) do { int lo_ = lane; asm volatile("" : "+v"(lo_)); _Pragma("unroll") for (int i = 0; i < 4; ++i) gv[hf_][i] = *(const u32x4*)(Gin + go + 64 * (hf_) + (size_t)(8 * i + (lo_ >> 3)) * 1024 + (lo_ & 7) * 8); } while (0)
      UV_GATE(0); SBAR(); UV_LD(0); SBAR(); UV_MM(0); SBAR(); UV_LD(1); SBAR(); UV_MM(1); SBAR(); UV_GATE(1); SBAR();
      asm volatile("s_waitcnt lgkmcnt(0)\n\ts_barrier" ::: "memory");
#undef UV_GATE
#undef UV_LD
#undef UV_MM
    }
    SBAR();
#pragma unroll
    for (int hf = 0; hf < 2; ++hf) {
        { int lo_ = lane; asm volatile("" : "+v"(lo_));
#pragma unroll
          for (int i = 0; i < 4; ++i) *(LAS u32x4*)(stg + (8 * i + (lo_ >> 3)) * STG_ROW + (lo_ & 7) * 16) = gv[hf][i]; }
        stage_gated_out(stg, o2[2 * hf], o2[2 * hf + 1], Gout + go + 64 * hf, lane);
        if (hf == 0) { const int kl_ = k + 1 < nun ? k + 1 : k; MLA_COORDS(kl_, bl_, hl_, ql_); MLA_UQ_LOAD(bl_, hl_, ql_); }
    }
    if (k + 1 < nun) { MLA_COORDS(k + 1, bn_, hn_, qn_); MLA_UQ(bn_, hn_, qn_, 4); }
    }
#undef MLA_UQ
#undef MLA_UQ_LOAD
#undef MLA_WQ_DMA
#undef MLA_COORDS
#undef MLA_OFFS
#undef MLA_REQUEST
#undef MLA_DMA_K
#undef MLA_DMA_V
#undef MLA_DMA_K1
#undef MLA_DMA_R
#undef MLA_DMA_V1
}
}

#ifndef PH_MASK
#define PH_MASK 0x7fffu
#endif
#define PH_ON(k) ((PH_MASK >> (k)) & 1u)
#ifndef LB_WAVES
#define LB_WAVES 2
#endif
#ifndef PROBE_PHASE
#define PROBE_PHASE (-1)
#endif
__global__ void __launch_bounds__(NWAVES * 64, LB_WAVES) skel_fwd(Args args) {
    using namespace cfg;
    extern __shared__ __attribute__((aligned(16))) unsigned char lds[];
    Frame F;
    F.lds = (LAS unsigned char*)lds;
    F.MISC = (volatile LAS unsigned*)(F.lds + MISC_OFF);
    F.tid = threadIdx.x; F.lane = F.tid & 63; F.wave = __builtin_amdgcn_readfirstlane(F.tid >> 6);
    F.G = gridDim.x; { const int bx = blockIdx.x; F.vcu = (F.G % 8 == 0) ? (bx % 8) * (F.G / 8) + bx / 8 : bx; }
    unsigned char* ws = args.ws;
    for (int u = F.tid; u < (LDS_BYTES - LDSCTL_OFF) / 4; u += NWAVES * 64) ((LAS unsigned*)(F.lds + LDSCTL_OFF))[u] = 0u;
    __syncthreads();
    const int lo = args.ph_lo, hi = args.ph_hi;
    XcdBarrier bar; bar.bar = (unsigned*)(ws + WS_CTL) + CW_BAR + args.li * XCD_BAR_WORDS; bar.x = 0; bar.st = nullptr;
    if (hi - lo > 1) bar = xcd_barrier_post((unsigned*)(ws + WS_CTL) + CW_BAR + args.li * XCD_BAR_WORDS, F.MISC + 8);
#define IN(k) (lo <= (k) && (k) < hi)
#define SEAM(k) do { if (IN(k) && IN((k) + 1)) xcd_barrier(bar); } while (0)
    const bf16_t* xb = (const bf16_t*)(ws + WS_XB); float* ss = (float*)(ws + WS_SS);
    bf16_t* bA = (bf16_t*)(ws + WS_A); bf16_t* bB = (bf16_t*)(ws + WS_B); bf16_t* bC = (bf16_t*)(ws + WS_C); bf16_t* bG = (bf16_t*)(ws + WS_G);
    bf16_t* bQL = (bf16_t*)(ws + WS_QL); bf16_t* bKV2 = (bf16_t*)(ws + WS_KV2); float* ssq = (float*)(ws + WS_SSQ); float* sskv = (float*)(ws + WS_SSKV);
    const int bx = (int)blockIdx.x;
#define WPTR(off) ((const bf16_t*)(ws + WS_W + (off)))
#define OUT_PHASE(Aptr, Woff, XF32, F32O, LNEXT) do { pg8::Gemm g{(Aptr), WPTR(Woff), M, 1024, 1024}; pg8::StaticOrder So; So.init(M, 1024, F.G, bx); \
        pg8::EpiOutR<XF32, F32O> E{args.in[0], args.out, (bf16_t*)(ws + WS_XB), ss + (LNEXT) * M}; pg8::gemm_phase<pg8::EpiOutR<XF32, F32O>, pg8::StaticOrder, true, true>(F.lds + RING_OFF, g, So, E); } while (0)
#define SB_IN_PHASE(Wqkg, Wv, LYR) do { const float* ssl = ss + (LYR) * M; { pg8::Gemm g{xb, WPTR(Wqkg), M, 3072, 1024}; pg8::StaticOrder So; So.init(M, 3072, F.G, bx); \
          pg8::EpiSbQKG E{ssl, ws}; pg8::gemm_phase<pg8::EpiSbQKG, pg8::StaticOrder, true, true>(F.lds + RING_OFF, g, So, E); } \
        { pg8::Gemm g{WPTR(Wv), xb, 1024, M, 1024}; pg8::StaticOrder So; So.init(1024, M, F.G, bx); \
          pg8::EpiVt E{ssl, bC, 16}; pg8::gemm_phase<pg8::EpiVt, pg8::StaticOrder, true, true>(F.lds + RING_OFF, g, So, E); } } while (0)

    if (IN(0) && PH_ON(0)) { if (PROBE_PHASE == 0) p0_prologue(phase_frame(F), args); p0_prologue(phase_frame(F), args); SEAM(0); }
    if (IN(1) && PH_ON(1)) { if (PROBE_PHASE == 1) SB_IN_PHASE(W_L0_QKG, W_L0_V, 0); SB_IN_PHASE(W_L0_QKG, W_L0_V, 0); SEAM(1); }
    if (IN(2) && PH_ON(2)) { if (PROBE_PHASE == 2) att::sb_attn_phase(phase_frame(F), bA, bB, bC, bG, (bf16_t*)args.out); att::sb_attn_phase(phase_frame(F), bA, bB, bC, bG, bA); SEAM(2); }
    if (IN(3) && PH_ON(3)) { if (PROBE_PHASE == 3) OUT_PHASE(bA, W_L0_O, true, false, 1); OUT_PHASE(bA, W_L0_O, true, false, 1); SEAM(3); }
    if (IN(4) && PH_ON(4)) { for (int rep_ = (PROBE_PHASE == 4 ? 0 : 1); rep_ < 2; ++rep_) { pg8::Gemm g{xb, WPTR(W_L1_IN), M, 1536, 1024}; pg8::StaticOrder So; So.init(M, 1536, F.G, bx);
        pg8::EpiMlaIn E{ss + 1 * M, ws}; pg8::gemm_phase<pg8::EpiMlaIn, pg8::StaticOrder, true, true>(F.lds + RING_OFF, g, So, E); } SEAM(4); }
    if (IN(5) && PH_ON(5)) { for (int rep_ = (PROBE_PHASE == 5 ? 0 : 1); rep_ < 2; ++rep_) {
        { pg8::Gemm g{bKV2, WPTR(W_L1_UK), M, 1024, 256}; pg8::StaticOrder So; So.init(M, 1024, F.G, bx);
          pg8::EpiUkv E{sskv, bB, bC, (float*)(ws + WS_SSN)}; pg8::gemm_phase<pg8::EpiUkv, pg8::StaticOrder, true, true>(F.lds + RING_OFF, g, So, E); } }
        SEAM(5); }
    if (IN(6) && PH_ON(6)) { mla_prep(phase_frame(F), args); SEAM(6); }
    if (IN(7) && PH_ON(7)) { constexpr int nrep_ = PROBE_PHASE == 7 ? 2 : 1; for (int rep_ = 0; rep_ < nrep_; ++rep_) att::mla_attn_phase(phase_frame(F), bA, bG, rep_ == nrep_ - 1 ? bG : (bf16_t*)args.out, ws); SEAM(7); }
    if (IN(8) && PH_ON(8)) { OUT_PHASE(bG, W_L1_O, false, false, 2); SEAM(8); }
    if (IN(9) && PH_ON(9)) { for (int rep_ = (PROBE_PHASE == 9 ? 0 : 1); rep_ < 2; ++rep_) {
        { pg8::Gemm g{xb, WPTR(W_L2_QKG), M, 2304, 1024}; pg8::StaticOrder So; So.init(M, 2304, F.G, bx);
          pg8::EpiSwaQKG E{ss + 2 * M, args.in[15], args.in[16], ws}; pg8::gemm_phase<pg8::EpiSwaQKG, pg8::StaticOrder, true, true>(F.lds + RING_OFF, g, So, E); }
        { pg8::Gemm g{WPTR(W_L2_V), xb, 256, M, 1024}; pg8::StaticOrder So; So.init(256, M, F.G, (bx + F.G / 2) % F.G);
          pg8::EpiVt E{ss + 2 * M, bC, 4}; pg8::gemm_phase<pg8::EpiVt, pg8::StaticOrder, true, true>(F.lds + RING_OFF, g, So, E); } }
        SEAM(9); }
    if (IN(10) && PH_ON(10)) { if (PROBE_PHASE == 10) att::swa_attn_phase(phase_frame(F), bA, bB, bC, bG, args.in[17], (bf16_t*)args.out); att::swa_attn_phase(phase_frame(F), bA, bB, bC, bG, args.in[17], bA); SEAM(10); }
    if (IN(11) && PH_ON(11)) { OUT_PHASE(bA, W_L2_O, false, false, 3); SEAM(11); }
    if (IN(12) && PH_ON(12)) { SB_IN_PHASE(W_L3_QKG, W_L3_V, 3); SEAM(12); }
    if (IN(13) && PH_ON(13)) { att::sb_attn_phase(phase_frame(F), bA, bB, bC, bG, bA); SEAM(13); }
    if (IN(14) && PH_ON(14)) { OUT_PHASE(bA, W_L3_O, false, true, 0); }
#undef IN
#undef SEAM
#undef OUT_PHASE
#undef SB_IN_PHASE
#undef WPTR
}

extern "C" void kernel_launch(void* const* d_in, const int* in_sizes, int n_in, void* d_out, int out_size, void* d_ws, size_t ws_size, hipStream_t stream) {
    using namespace cfg;
    static int grid = 0;
    if (grid == 0) {
        if (n_in != 22 || in_sizes[0] != M * D || out_size != M * D || ws_size < WS_END) { fprintf(stderr, "kernel_launch: unexpected shapes (n_in %d, ws %zu); nothing launched\n", n_in, ws_size); grid = -1; return; }
        int dev = 0, cus = 0, per_cu = 0;
        if (hipGetDevice(&dev) != hipSuccess || hipDeviceGetAttribute(&cus, hipDeviceAttributeMultiprocessorCount, dev) != hipSuccess) { grid = -1; return; }
        if (hipFuncSetAttribute((const void*)skel_fwd, hipFuncAttributeMaxDynamicSharedMemorySize, LDS_BYTES) != hipSuccess) { fprintf(stderr, "kernel_launch: hipFuncSetAttribute failed\n"); grid = -1; return; }
        if (hipOccupancyMaxActiveBlocksPerMultiprocessor(&per_cu, (const void*)skel_fwd, NWAVES * 64, LDS_BYTES) != hipSuccess || per_cu < 1)
            fprintf(stderr, "kernel_launch: note: occupancy query reports %d workgroups per CU\n", per_cu);
        (void)hipGetLastError();
        grid = cus;
    }
    if (grid < 0) return;
    if (hipMemsetAsync((char*)d_ws + WS_CTL, 0, CTL_ZERO_BYTES, stream) != hipSuccess) return;
    Args a{};
    for (int i = 0; i < 22; ++i) a.in[i] = (const float*)d_in[i];
    a.out = (float*)d_out; a.ws = (unsigned char*)d_ws;
    a.ph_lo = 0; a.ph_hi = N_PHASES; a.li = 0;
    hipLaunchKernelGGL(skel_fwd, dim3(grid), dim3(NWAVES * 64), LDS_BYTES, stream, a);
}
```

```cpp
#include <hip/hip_runtime.h>
#include <cstdio>
#include <cstdint>
#include <cmath>

typedef unsigned short bf16_t;

namespace cfg {
constexpr int B = 8, S = 4096, D = 1024, M = B * S;
constexpr float NORM_EPS = 1e-6f;
constexpr float LOG2E = 1.4426950408889634f;
constexpr float SB_QSCALE = 0.125f * LOG2E;
constexpr float SWA_QSCALE = 0.125f * LOG2E;
constexpr float MLA_QSCALE = 0.07216878364870323f * LOG2E;
constexpr size_t MiB = 1u << 20;
constexpr size_t WS_CTL = 0, CTL_ZERO_BYTES = 768 * 1024;
constexpr size_t WS_SSN = 468 * MiB;
constexpr size_t WS_RK = 2 * MiB;
constexpr size_t WS_SS = 256 * 1024;
constexpr size_t WS_SSQ = 3 * MiB;
constexpr size_t WS_SSKV = 3 * MiB + 512 * 1024;
constexpr size_t WS_ROPE = 4 * MiB;
constexpr size_t WS_GPERM = 5 * MiB;
constexpr size_t WS_W = 8 * MiB;
constexpr size_t WS_XB = 48 * MiB;
constexpr size_t WS_A = 112 * MiB;
constexpr size_t WS_B = 208 * MiB;
constexpr size_t WS_C = 304 * MiB;
constexpr size_t WS_G = 368 * MiB;
constexpr size_t WS_QL = 432 * MiB;
constexpr size_t WS_KV2 = 448 * MiB;
constexpr size_t WS_KR = 464 * MiB;
constexpr size_t WS_KVN = 472 * MiB;
constexpr size_t WS_END = 480 * MiB;
}

__host__ __device__ __forceinline__ float bf2f(bf16_t v) { return __builtin_bit_cast(float, (unsigned)v << 16); }
__host__ __device__ __forceinline__ bf16_t f2bf(float f) { unsigned u = __builtin_bit_cast(unsigned, f); return (bf16_t)((u + 0x7fffu + ((u >> 16) & 1u)) >> 16); }

__host__ __device__ __forceinline__ int kperm_inv(int k) { return (k & 3) | (((k >> 4) & 1) << 2) | (((k >> 2) & 3) << 3); }
__host__ __device__ __forceinline__ size_t kt_idx(int bh, int s, int d) { return ((((size_t)bh * 128 + (s >> 5)) * 4 + (d >> 4)) * 64 + 32 * ((d >> 3) & 1) + kperm_inv(s & 31)) * 8 + (d & 7); }
__host__ __device__ __forceinline__ size_t vt_idx(int bh, int d, int s) { return ((((size_t)bh * 128 + (s >> 5)) * 4 + ((d >> 5) * 2 + ((s >> 3) & 1))) * 64 + 32 * ((s >> 4) & 1) + (d & 31)) * 8 + (s & 7); }
namespace pg8 {
#define PG8_LAS __attribute__((address_space(3)))
typedef unsigned short bf16_t;
typedef short bf16x8 __attribute__((ext_vector_type(8)));
typedef float f32x4 __attribute__((ext_vector_type(4)));
typedef unsigned u32x4 __attribute__((ext_vector_type(4)));
constexpr int BM = 256, BK = 64, HALF = 128, HTB = HALF * BK * 2  , STAGE_BYTES = 8 * HTB, NXCD = 8, WGM = 8;

__host__ __device__ __forceinline__ int lds_byte(int r, int c) { const int st = (r >> 4) * 2 + (c >> 5), rr = r & 15, cc = c & 31, ob = rr * 64 + cc * 2; return st * 1024 + (ob ^ (((ob >> 9) & 1) << 5)); }
__host__ __device__ __forceinline__ void stage_rc(int b, int& R, int& C) { const int st = b / 1024, sb = b % 1024, swz = sb ^ (((sb >> 9) & 1) << 5); R = (st >> 1) * 16 + swz / 64; C = (st & 1) * 32 + (swz % 64) / 2; }
__host__ __device__ __forceinline__ int perm32(int rho) { const int n = rho >> 4, i = rho & 15; return 8 * (i >> 2) + 4 * n + (i & 3); }

struct Unit { int pm, pn; };
struct Gemm { const bf16_t* A; const bf16_t* Bt; int M, N, K; };

struct StaticOrder {
    int nM, nN, nwg, G, c;
    __host__ __device__ void init(int M, int N, int G_, int c_) { nM = M / BM; nN = N / BM; nwg = nM * nN; G = G_; c = c_; }
    __host__ __device__ bool next(int i, Unit& u) const {
        const long L = (long)i * G + c; if (L >= nwg) return false;
        int wgid = (int)L; { const int q = nwg / NXCD, r = nwg % NXCD, xcd = wgid % NXCD, off = wgid / NXCD; wgid = (xcd < r ? xcd * (q + 1) : r * (q + 1) + (xcd - r) * q) + off; }
        const int nig = WGM * nN, gid = wgid / nig, fm = gid * WGM, gsz = (nM - fm) < WGM ? (nM - fm) : WGM;
        u.pm = fm + ((wgid % nig) % gsz); u.pn = (wgid % nig) / gsz; return true;
    }
    __device__ __forceinline__ void a_ready(const Unit&) const {}
    __device__ __forceinline__ void done(const Unit&) const {}
};


__device__ __forceinline__ unsigned cvt_pk_bf16(float lo, float hi) { unsigned r; asm volatile("v_cvt_pk_bf16_f32 %0, %1, %2" : "=v"(r) : "v"(lo), "v"(hi)); return r; }
typedef unsigned u32x2 __attribute__((ext_vector_type(2)));
__device__ __forceinline__ u32x4 pack8(const f32x4 v0, const f32x4 v1) { u32x4 w; w.x = cvt_pk_bf16(v0[0], v0[1]); w.y = cvt_pk_bf16(v0[2], v0[3]); w.z = cvt_pk_bf16(v1[0], v1[1]); w.w = cvt_pk_bf16(v1[2], v1[3]); return w; }
__device__ __forceinline__ float hsum4(const f32x4 v) { return (v[0] + v[1]) + (v[2] + v[3]); }
__device__ __forceinline__ float dot4(const f32x4 v) { return (v[0] * v[0] + v[1] * v[1]) + (v[2] * v[2] + v[3] * v[3]); }
__device__ __forceinline__ float rs_from16(const float* ss, int row) { return __builtin_amdgcn_rsqf(ss[row] * (1.0f / 1024.0f) + cfg::NORM_EPS); }
__device__ __forceinline__ float rs_from4(const float* ss, int row, float inv_n) {
    const f32x4 s = *(const f32x4*)(ss + (size_t)row * 4);
    return __builtin_amdgcn_rsqf(hsum4(s) * inv_n + cfg::NORM_EPS);
}

struct EpiSbQKG {
    static constexpr bool PERM = true, AFTER_DRAIN = false;
    const float* ss; unsigned char* ws;
    __device__ __forceinline__ void operator()(const f32x4 (&acc)[2][2][4][2], const Unit& u, int wr, int wc, int fr, int fq) const {
        const int t = u.pn >> 2;
        bf16_t* base = (bf16_t*)(ws + (t == 0 ? cfg::WS_A : (t == 1 ? cfg::WS_B : cfg::WS_G)));
        const float sc = t == 0 ? cfg::SB_QSCALE : 1.0f;
        const int col0 = (u.pn & 3) * BM + wc * 32 + 8 * fq, row0 = u.pm * BM + wr * 64 + fr;
#pragma unroll
        for (int ai = 0; ai < 2; ++ai)
#pragma unroll
            for (int m = 0; m < 4; ++m) { const int row = row0 + ai * HALF + m * 16; const float r = rs_from16(ss, row) * sc;
#pragma unroll
                for (int bj = 0; bj < 2; ++bj) { const int c = col0 + bj * HALF;
                    bf16_t* dst = t == 1 ? base + kt_idx((row >> 12) * 16 + (c >> 6), row & 4095, c & 63) : base + (size_t)row * 1024 + c;
                    *(u32x4*)dst = pack8(acc[ai][bj][m][0] * r, acc[ai][bj][m][1] * r); } }
    }
};
struct EpiVt {
    static constexpr bool PERM = true, AFTER_DRAIN = false;
    const float* ss; bf16_t* Vt; int nheads;
    __device__ __forceinline__ void operator()(const f32x4 (&acc)[2][2][4][2], const Unit& u, int wr, int wc, int fr, int fq) const {
        const int tok0 = u.pn * BM + wc * 32 + 8 * fq, r0 = u.pm * BM + wr * 64 + fr;
#pragma unroll
        for (int bj = 0; bj < 2; ++bj) { const int tok = tok0 + bj * HALF, b = tok >> 12, s = tok & 4095;
            f32x4 ra, rb;
#pragma unroll
            for (int j = 0; j < 4; ++j) { ra[j] = rs_from16(ss, tok + j); rb[j] = rs_from16(ss, tok + 4 + j); }
#pragma unroll
            for (int ai = 0; ai < 2; ++ai)
#pragma unroll
                for (int m = 0; m < 4; ++m) { const int r = r0 + ai * HALF + m * 16;
                    *(u32x4*)(Vt + vt_idx(b * nheads + (r >> 6), r & 63, s)) = pack8(acc[ai][bj][m][0] * ra, acc[ai][bj][m][1] * rb); } }
    }
};
template <bool XF32IN, bool F32OUT> struct EpiOutR {
    static constexpr bool PERM = true, AFTER_DRAIN = false;
    const float* xin; float* out; bf16_t* xb; float* ss;
    __device__ __forceinline__ void operator()(const f32x4 (&acc)[2][2][4][2], const Unit& u, int wr, int wc, int fr, int fq) const {
        const int col0 = u.pn * BM + wc * 32 + 8 * fq, row0 = u.pm * BM + wr * 64 + fr;
#pragma unroll
        for (int ai = 0; ai < 2; ++ai) {
            u32x4 xw[4][2]; f32x4 xf[4][2][2];
#pragma unroll
            for (int m = 0; m < 4; ++m)
#pragma unroll
                for (int bj = 0; bj < 2; ++bj) { const size_t o = (size_t)(row0 + ai * HALF + m * 16) * 1024 + col0 + bj * HALF;
                    if (XF32IN) { xf[m][bj][0] = *(const f32x4*)(xin + o); xf[m][bj][1] = *(const f32x4*)(xin + o + 4); } else xw[m][bj] = *(const u32x4*)(xb + o); }
#pragma unroll
            for (int m = 0; m < 4; ++m) { const int row = row0 + ai * HALF + m * 16; const size_t off = (size_t)row * 1024 + col0; float sq = 0.f;
#pragma unroll
                for (int bj = 0; bj < 2; ++bj) { const size_t o = off + bj * HALF; f32x4 x0, x1;
                    if (XF32IN) { x0 = xf[m][bj][0]; x1 = xf[m][bj][1]; }
                    else { const u32x4 w = xw[m][bj]; x0 = (f32x4){__uint_as_float(w.x << 16), __uint_as_float(w.x & 0xffff0000u), __uint_as_float(w.y << 16), __uint_as_float(w.y & 0xffff0000u)};
                           x1 = (f32x4){__uint_as_float(w.z << 16), __uint_as_float(w.z & 0xffff0000u), __uint_as_float(w.w << 16), __uint_as_float(w.w & 0xffff0000u)}; }
                    const f32x4 v0 = x0 + acc[ai][bj][m][0], v1 = x1 + acc[ai][bj][m][1];
                    if (F32OUT) { *(f32x4*)(out + o) = v0; *(f32x4*)(out + o + 4) = v1; }
                    else { *(u32x4*)(xb + o) = pack8(v0, v1); sq += dot4(v0) + dot4(v1); } }
                if (!F32OUT) { sq += __shfl_xor(sq, 16); sq += __shfl_xor(sq, 32); if (fq == 0) atomicAdd(ss + row, sq); } }
            asm volatile("" ::: "memory"); }
    }
};
struct EpiMlaIn {
    static constexpr bool PERM = true, AFTER_DRAIN = false;
    const float* ss; unsigned char* ws;
    __device__ __forceinline__ void operator()(const f32x4 (&acc)[2][2][4][2], const Unit& u, int wr, int wc, int fr, int fq) const {
        const int pn = u.pn;
        bf16_t* base = (bf16_t*)(ws + (pn == 0 ? cfg::WS_QL : (pn < 5 ? cfg::WS_G : cfg::WS_KV2)));
        float* sqdst = (float*)(ws + (pn == 0 ? cfg::WS_SSQ : cfg::WS_SSKV));
        const int ld = (pn == 0 || pn == 5) ? 256 : 1024, cbase = (pn == 0 || pn == 5) ? 0 : (pn - 1) * BM;
        const int col0 = cbase + wc * 32 + 8 * fq, row0 = u.pm * BM + wr * 64 + fr;
#pragma unroll
        for (int ai = 0; ai < 2; ++ai)
#pragma unroll
            for (int m = 0; m < 4; ++m) { const int row = row0 + ai * HALF + m * 16; const float r = rs_from16(ss, row); bf16_t* rowp = base + (size_t)row * ld + col0;
                float sq[2];
#pragma unroll
                for (int bj = 0; bj < 2; ++bj) { const f32x4 v0 = acc[ai][bj][m][0] * r, v1 = acc[ai][bj][m][1] * r; sq[bj] = dot4(v0) + dot4(v1); *(u32x4*)(rowp + bj * HALF) = pack8(v0, v1); }
                if (pn == 0 || pn == 5) { float s = pn == 0 ? sq[0] + sq[1] : sq[0]; s += __shfl_xor(s, 16); s += __shfl_xor(s, 32);
                    if (fq == 0) sqdst[(size_t)row * 4 + wc] = s; } }
    }
};
struct EpiUq {
    static constexpr bool PERM = true, AFTER_DRAIN = false;
    const float* ssq; bf16_t* Qm;
    __device__ __forceinline__ void operator()(const f32x4 (&acc)[2][2][4][2], const Unit& u, int wr, int wc, int fr, int fq) const {
        const int col0 = u.pn * BM + wc * 32 + 8 * fq, row0 = u.pm * BM + wr * 64 + fr;
#pragma unroll
        for (int ai = 0; ai < 2; ++ai)
#pragma unroll
            for (int m = 0; m < 4; ++m) { const int row = row0 + ai * HALF + m * 16; const float r = rs_from4(ssq, row, 1.0f / 256.0f); bf16_t* rowp = Qm + (size_t)row * 1536 + col0;
#pragma unroll
                for (int bj = 0; bj < 2; ++bj) *(u32x4*)(rowp + bj * HALF) = pack8(acc[ai][bj][m][0] * r, acc[ai][bj][m][1] * r); }
    }
};
struct EpiUkv {
    static constexpr bool PERM = true, AFTER_DRAIN = false;
    const float* sskv; bf16_t* Kn; bf16_t* Vm; float* ssn;
    __device__ __forceinline__ void operator()(const f32x4 (&acc)[2][2][4][2], const Unit& u, int wr, int wc, int fr, int fq) const {
        const int row0 = u.pm * BM + wr * 64 + fr;
#pragma unroll
        for (int ai = 0; ai < 2; ++ai)
#pragma unroll
            for (int m = 0; m < 4; ++m) { const int row = row0 + ai * HALF + m * 16; const float r = rs_from4(sskv, row, 1.0f / 128.0f);
#pragma unroll
                for (int bj = 0; bj < 2; ++bj) { const f32x4 k0 = acc[ai][bj][m][0] * r, k1 = acc[ai][bj][m][1] * r;
                    float sq = dot4(k0) + dot4(k1); sq += __shfl_xor(sq, 16); sq += __shfl_xor(sq, 32);
                    if (fq == 0) ssn[((size_t)row * 8 + 2 * u.pn + bj) * 4 + wc] = sq; } }
    }
};
struct EpiSwaQKG {
    static constexpr bool PERM = true, AFTER_DRAIN = false;
    const float* ss; const float* gq; const float* gk; unsigned char* ws;
    __device__ __forceinline__ void operator()(const f32x4 (&acc)[2][2][4][2], const Unit& u, int wr, int wc, int fr, int fq) const {
        const int pn = u.pn; const bool normed = pn < 5;
        bf16_t* base = (bf16_t*)(ws + (pn < 4 ? cfg::WS_A : (pn == 4 ? cfg::WS_B : cfg::WS_G)));
        const int ld = pn == 4 ? 256 : 1024, cbase = pn < 4 ? pn * BM : (pn == 4 ? 0 : (pn - 5) * BM);
        const int col0 = cbase + wc * 64 + 8 * fq, row0 = u.pm * BM + wr * 64 + fr;
        f32x4 gv[2][2];
#pragma unroll
        for (int bj = 0; bj < 2; ++bj)
#pragma unroll
            for (int n = 0; n < 2; ++n) { gv[bj][n] = (f32x4){1.f, 1.f, 1.f, 1.f};
                const f32x4 a = *(const f32x4*)(gq + 32 * bj + 8 * fq + 4 * n) * cfg::SWA_QSCALE, b = *(const f32x4*)(gk + 32 * bj + 8 * fq + 4 * n);
                if (normed) gv[bj][n] = pn < 4 ? a : b; }
#pragma unroll
        for (int ai = 0; ai < 2; ++ai)
#pragma unroll
            for (int m = 0; m < 4; ++m) { const int row = row0 + ai * HALF + m * 16; float r = rs_from16(ss, row); bf16_t* rowp = base + (size_t)row * ld + col0;
                if (normed) { float sq = (dot4(acc[ai][0][m][0]) + dot4(acc[ai][0][m][1])) + (dot4(acc[ai][1][m][0]) + dot4(acc[ai][1][m][1]));
                    sq += __shfl_xor(sq, 16); sq += __shfl_xor(sq, 32);
                    r = r * __builtin_amdgcn_rsqf(sq * r * r * (1.0f / 64.0f) + cfg::NORM_EPS); }
#pragma unroll
                for (int bj = 0; bj < 2; ++bj) { bf16_t* dst = pn == 4 ? base + kt_idx((row >> 12) * 4 + wc, row & 4095, 32 * bj + 8 * fq) : rowp + bj * 32;
                    *(u32x4*)dst = pack8(acc[ai][bj][m][0] * r * gv[bj][0], acc[ai][bj][m][1] * r * gv[bj][1]); } }
    }
};

template <class Epi, class Sched, bool ALIGN_EPI = false, bool SP2 = false>
__device__ __forceinline__ void gemm_phase(PG8_LAS unsigned char* lds, const Gemm g, const Sched& S, const Epi& E) {
    int tid_ = threadIdx.x; asm volatile("" : "+v"(tid_));
    const int tid = tid_, wid = __builtin_amdgcn_readfirstlane(tid >> 6), lane = tid & 63, wr = wid >> 2, wc = wid & 3, fr = lane & 15, fq = lane >> 4;
    const int K = g.K, nt = K / BK;
    unsigned voffA[2], voffB[2];
#pragma unroll
    for (int i = 0; i < 2; ++i) { int R, C; stage_rc(tid * 16 + i * 8192, R, C); const int Rb = Epi::PERM ? ((R & ~31) + perm32(R & 31)) : R;
        voffA[i] = (unsigned)(R * K + C) * 2u; voffB[i] = (unsigned)(Rb * K + C) * 2u; }
    const size_t kstep = (size_t)(BK * 2);
    const size_t hstep = (size_t)HALF * K * 2;
    const size_t tstep = 2 * hstep;
    const unsigned ldsw = (unsigned)wid * 1024u;
    const int aoff = lds_byte(wr * 64 + fr, fq * 8), boff = lds_byte(wc * 32 + fr, fq * 8);
#define PG8_SA(b, h) (((b) * 2 + (h)) * HTB)
#define PG8_SB(b, h) ((4 + (b) * 2 + (h)) * HTB)
#define PG8_STAGE(bufoff, gbase, voff) do { _Pragma("unroll") for (int _i = 0; _i < 2; ++_i) \
        __builtin_amdgcn_global_load_lds((const unsigned*)((const char*)(gbase) + (voff)[_i]), (PG8_LAS unsigned*)(lds + (bufoff) + ldsw + _i * 8192), 16, 0, 0); } while (0)
#define PG8_LDA(dst, b, h) do { _Pragma("unroll") for (int m = 0; m < 4; ++m) _Pragma("unroll") for (int k = 0; k < 2; ++k) dst[m][k] = *(const PG8_LAS bf16x8*)(lds + PG8_SA(b, h) + aoff + m * 2048 + k * 1024); } while (0)
#define PG8_LDB(dst, b, h) do { _Pragma("unroll") for (int n = 0; n < 2; ++n) _Pragma("unroll") for (int k = 0; k < 2; ++k) dst[n][k] = *(const PG8_LAS bf16x8*)(lds + PG8_SB(b, h) + boff + n * 2048 + k * 1024); } while (0)
#define PG8_MMA(ai, bj, At, Bt) do { __builtin_amdgcn_s_setprio(1); _Pragma("unroll") for (int m = 0; m < 4; ++m) _Pragma("unroll") for (int n = 0; n < 2; ++n) _Pragma("unroll") for (int k = 0; k < 2; ++k) \
        acc[ai][bj][m][n] = __builtin_amdgcn_mfma_f32_16x16x32_bf16(Bt[n][k], At[m][k], acc[ai][bj][m][n], 0, 0, 0); __builtin_amdgcn_s_setprio(0); } while (0)
#define PG8_WAIT_V(n) asm volatile("s_waitcnt vmcnt(" #n ")" ::: "memory")
#define PG8_WAIT_L(n) asm volatile("s_waitcnt lgkmcnt(" #n ")" ::: "memory")
#define PG8_BAR __builtin_amdgcn_s_barrier()
#define PG8_SCHED __builtin_amdgcn_sched_barrier(0)
    Unit cur, nxt; int ui = 0;
    if (!S.next(0, cur)) return;
    f32x4 acc[2][2][4][2];
#pragma unroll
    for (int a = 0; a < 2; ++a)
#pragma unroll
        for (int b = 0; b < 2; ++b)
#pragma unroll
            for (int m = 0; m < 4; ++m)
#pragma unroll
                for (int n = 0; n < 2; ++n) acc[a][b][m][n] = (f32x4){0.f, 0.f, 0.f, 0.f};
    bf16x8 At[4][2], B0[2][2], B1[2][2];
    const char* cA = (const char*)g.A + (size_t)cur.pm * tstep; const char* cB = (const char*)g.Bt + (size_t)cur.pn * tstep;
    S.a_ready(cur);
    if constexpr (SP2) {
        PG8_STAGE(PG8_SB(0, 0), cB, voffB); PG8_STAGE(PG8_SB(0, 1), cB + hstep, voffB); PG8_STAGE(PG8_SA(0, 0), cA, voffA); PG8_STAGE(PG8_SA(0, 1), cA + hstep, voffA);
        if (wr == 1) PG8_BAR;
        PG8_WAIT_V(2); PG8_BAR;
        PG8_STAGE(PG8_SB(1, 0), cB + kstep, voffB); PG8_STAGE(PG8_SA(1, 0), cA + kstep, voffA); PG8_STAGE(PG8_SB(1, 1), cB + hstep + kstep, voffB);
        PG8_WAIT_V(6); PG8_BAR;
    } else {
        PG8_STAGE(PG8_SB(0, 0), cB, voffB); PG8_STAGE(PG8_SA(0, 0), cA, voffA); PG8_STAGE(PG8_SB(0, 1), cB + hstep, voffB); PG8_STAGE(PG8_SA(0, 1), cA + hstep, voffA);
        if (wr == 1) PG8_BAR;
        PG8_WAIT_V(4); PG8_BAR;
        PG8_STAGE(PG8_SB(1, 0), cB + kstep, voffB); PG8_STAGE(PG8_SA(1, 0), cA + kstep, voffA); PG8_STAGE(PG8_SB(1, 1), cB + hstep + kstep, voffB);
        PG8_WAIT_V(6); PG8_BAR;
    }
    for (;;) {
        const bool has_next = S.next(ui + 1, nxt);
        const char* nA = has_next ? (const char*)g.A + (size_t)nxt.pm * tstep : cA; const char* nB = has_next ? (const char*)g.Bt + (size_t)nxt.pn * tstep : cB;
        for (int t = 0; t < nt; t += 2) {
            const bool last = (t == nt - 2);
            const char* a1 = cA + (size_t)(t + 1) * kstep;
            const char* a2 = last ? nA : cA + (size_t)(t + 2) * kstep; const char* b2 = last ? nB : cB + (size_t)(t + 2) * kstep;
            const char* a3 = a2 + kstep; const char* b3 = b2 + kstep;
            if (last && has_next) S.a_ready(nxt);
            if constexpr (SP2) {
            PG8_LDB(B0, 0, 0); PG8_LDB(B1, 0, 1); PG8_SCHED; PG8_LDA(At, 0, 0); PG8_STAGE(PG8_SA(1, 1), a1 + hstep, voffA);
            PG8_WAIT_V(8); PG8_WAIT_L(0); PG8_BAR; PG8_MMA(0, 0, At, B0); PG8_MMA(0, 1, At, B1); PG8_BAR; PG8_SCHED;
            PG8_LDA(At, 0, 1); PG8_STAGE(PG8_SB(0, 0), b2, voffB); PG8_STAGE(PG8_SB(0, 1), b2 + hstep, voffB); PG8_STAGE(PG8_SA(0, 0), a2, voffA);
            PG8_WAIT_V(8); PG8_WAIT_L(0); PG8_BAR; PG8_MMA(1, 0, At, B0); PG8_MMA(1, 1, At, B1); PG8_BAR; PG8_SCHED;
            PG8_LDB(B0, 1, 0); PG8_LDB(B1, 1, 1); PG8_SCHED; PG8_LDA(At, 1, 0); PG8_STAGE(PG8_SA(0, 1), a2 + hstep, voffA);
            PG8_WAIT_V(8); PG8_WAIT_L(0); PG8_BAR; PG8_MMA(0, 0, At, B0); PG8_MMA(0, 1, At, B1); PG8_BAR; PG8_SCHED;
            PG8_LDA(At, 1, 1); PG8_STAGE(PG8_SB(1, 0), b3, voffB); PG8_STAGE(PG8_SB(1, 1), b3 + hstep, voffB); PG8_STAGE(PG8_SA(1, 0), a3, voffA);
            PG8_WAIT_V(8); PG8_WAIT_L(0); PG8_BAR; PG8_MMA(1, 0, At, B0); PG8_MMA(1, 1, At, B1); PG8_BAR; PG8_SCHED;
            } else {
            PG8_LDB(B0, 0, 0); PG8_SCHED; PG8_LDA(At, 0, 0); PG8_STAGE(PG8_SA(1, 1), a1 + hstep, voffA);
            PG8_WAIT_L(8); PG8_BAR; PG8_WAIT_L(0); PG8_MMA(0, 0, At, B0); PG8_BAR; PG8_SCHED;
            PG8_LDB(B1, 0, 1); PG8_STAGE(PG8_SB(0, 0), b2, voffB);
            PG8_BAR; PG8_WAIT_L(0); PG8_MMA(0, 1, At, B1); PG8_BAR;
            PG8_LDA(At, 0, 1); PG8_STAGE(PG8_SA(0, 0), a2, voffA);
            PG8_BAR; PG8_WAIT_L(0); PG8_MMA(1, 0, At, B0); PG8_BAR; PG8_SCHED;
            PG8_STAGE(PG8_SB(0, 1), b2 + hstep, voffB);
            PG8_WAIT_V(6); PG8_BAR; PG8_MMA(1, 1, At, B1); PG8_BAR;
            PG8_LDB(B0, 1, 0); PG8_SCHED; PG8_LDA(At, 1, 0); PG8_STAGE(PG8_SA(0, 1), a2 + hstep, voffA);
            PG8_WAIT_L(8); PG8_BAR; PG8_WAIT_L(0); PG8_MMA(0, 0, At, B0); PG8_BAR; PG8_SCHED;
            PG8_LDB(B1, 1, 1); PG8_STAGE(PG8_SB(1, 0), b3, voffB);
            PG8_BAR; PG8_WAIT_L(0); PG8_MMA(0, 1, At, B1); PG8_BAR;
            PG8_LDA(At, 1, 1); PG8_STAGE(PG8_SA(1, 0), a3, voffA);
            PG8_BAR; PG8_WAIT_L(0); PG8_MMA(1, 0, At, B0); PG8_BAR; PG8_SCHED;
            PG8_STAGE(PG8_SB(1, 1), b3 + hstep, voffB);
            PG8_WAIT_V(6); PG8_BAR; PG8_MMA(1, 1, At, B1); PG8_BAR;
            }
        }
        if constexpr (ALIGN_EPI) { if (wr == 0) PG8_BAR; }
        if constexpr (!Epi::AFTER_DRAIN) { E(acc, cur, wr, wc, fr, fq); S.done(cur); }
        if (!has_next) break;
#pragma unroll
        for (int a = 0; a < 2; ++a)
#pragma unroll
            for (int b = 0; b < 2; ++b)
#pragma unroll
                for (int m = 0; m < 4; ++m)
#pragma unroll
                    for (int n = 0; n < 2; ++n) acc[a][b][m][n] = (f32x4){0.f, 0.f, 0.f, 0.f};
        cur = nxt; cA = nA; cB = nB; ++ui;
        if constexpr (ALIGN_EPI) { if (wr == 1) PG8_BAR; }
    }
    PG8_WAIT_V(0);
    if constexpr (!ALIGN_EPI) { if (wr == 0) PG8_BAR; }
    PG8_BAR;
    if constexpr (Epi::AFTER_DRAIN) { E.fused(acc, cur, wr, wc, fr, fq, lds, wid, lane); S.done(cur); }
#undef PG8_SA
#undef PG8_SB
#undef PG8_STAGE
#undef PG8_LDA
#undef PG8_LDB
#undef PG8_MMA
#undef PG8_WAIT_V
#undef PG8_WAIT_L
#undef PG8_BAR
#undef PG8_SCHED
}
}

constexpr int NWAVES = 8;
constexpr int N_PHASES = 15;
constexpr int RING_OFF = 0, RING_BYTES = 159744;
constexpr int LDSCTL_OFF = RING_BYTES, MISC_OFF = LDSCTL_OFF + 320;
constexpr int LDS_BYTES = 163840;
constexpr int CW_BAR = 4096;

#define GAS __attribute__((address_space(1)))
#define LAS __attribute__((address_space(3)))
typedef unsigned v4u __attribute__((ext_vector_type(4)));
typedef float f32x4 __attribute__((ext_vector_type(4)));
typedef GAS unsigned gu32;
#define RLX_AGENT __ATOMIC_RELAXED, __HIP_MEMORY_SCOPE_AGENT
#define LDS_WAIT() asm volatile("s_waitcnt lgkmcnt(0)" ::: "memory")
#define VM_WAIT() asm volatile("s_waitcnt vmcnt(0)" ::: "memory")
__device__ __forceinline__ unsigned pk2(float lo, float hi) { return (unsigned)f2bf(lo) | ((unsigned)f2bf(hi) << 16); }

#define XB_TMO      128
#define XB_XCNT(j)  (256  + 64 * (j))
#define XB_XSUB(j)  (1280 + 64 * (j))
#define XB_XGEN(j)  (2304 + 64 * (j))
#define XB_TOP      3328
#define XB_TOPGEN   3392
#define XCD_BAR_WORDS 3456
#define XB_SPIN_CAP (1u << 18)

__device__ __forceinline__ unsigned xb_ld(unsigned* p)              { return __hip_atomic_load(p, __ATOMIC_RELAXED, __HIP_MEMORY_SCOPE_AGENT); }
__device__ __forceinline__ unsigned xb_add(unsigned* p, unsigned v) { return __hip_atomic_fetch_add(p, v, __ATOMIC_RELAXED, __HIP_MEMORY_SCOPE_AGENT); }
__device__ __forceinline__ unsigned xb_xcc_id() { return (unsigned)__builtin_amdgcn_s_getreg((3 << 11) | 20) & 0xFu; }
#define XB_SPIN(cond, bar) do { unsigned _sp = 0; while (cond) { __builtin_amdgcn_s_sleep(1); \
    if ((++_sp & 255u) == 0u) { if (xb_ld(&(bar)[XB_TMO])) break; if (_sp > XB_SPIN_CAP) { atomicAdd(&(bar)[XB_TMO], 1u); break; } } } } while (0)

struct XcdBarrier {
    unsigned* bar; unsigned x;
    volatile LAS unsigned* st;
};

__device__ __forceinline__ XcdBarrier xcd_barrier_post(unsigned* bar, volatile LAS unsigned* st) {
    XcdBarrier b; b.bar = bar; b.x = xb_xcc_id(); b.st = st;
    if (threadIdx.x == 0) (void)xb_add(&bar[XB_XCNT(b.x)], 1u);
    return b;
}
__device__ __forceinline__ void xcd_barrier_complete(unsigned* bar, unsigned x, unsigned& nloc, unsigned& nx) {
    const unsigned G = gridDim.x * gridDim.y * gridDim.z;
    unsigned sum, cnt, mine, sp = 0u;
    for (;;) {
        sum = 0u; cnt = 0u; mine = 0u;
#pragma unroll
        for (unsigned j = 0; j < 16; ++j) { const unsigned c = xb_ld(&bar[XB_XCNT(j)]); sum += c; cnt += (c > 0u) ? 1u : 0u; mine = (j == x) ? c : mine; }
        if (sum == G) break;
        __builtin_amdgcn_s_sleep(1);
        if ((++sp & 255u) == 0u) { if (xb_ld(&bar[XB_TMO])) break; if (sp > XB_SPIN_CAP) { atomicAdd(&bar[XB_TMO], 1u); break; } }
    }
    nloc = mine > 0u ? mine : 1u; nx = cnt > 0u ? cnt : 1u;
}

__device__ __forceinline__ void xcd_barrier(const XcdBarrier& b) {
    asm volatile("s_waitcnt vmcnt(0)" ::: "memory");
    __syncthreads();
    if (threadIdx.x == 0) {
        unsigned* bar = b.bar;
        __builtin_amdgcn_s_waitcnt(0);
        unsigned nloc = b.st[0], nx = b.st[1];
        if (nloc == 0u) { xcd_barrier_complete(bar, b.x, nloc, nx); b.st[0] = nloc; b.st[1] = nx; }
        const unsigned old = xb_add(&bar[XB_XSUB(b.x)], 1u);
        const unsigned gen = old / nloc;
        if (old + 1u == (gen + 1u) * nloc) {
            __builtin_amdgcn_fence(__ATOMIC_RELEASE, "agent");
            asm volatile("s_waitcnt vmcnt(0)" ::: "memory");
            const unsigned og = xb_add(&bar[XB_TOP], 1u);
            const unsigned tg = og / nx;
            if (og + 1u == (tg + 1u) * nx) xb_add(&bar[XB_TOPGEN], 1u);
            else XB_SPIN(xb_ld(&bar[XB_TOPGEN]) == tg, bar);
            __builtin_amdgcn_fence(__ATOMIC_ACQUIRE, "agent");
            xb_add(&bar[XB_XGEN(b.x)], 1u);
            asm volatile("s_waitcnt vmcnt(0)" ::: "memory");
        } else {
            XB_SPIN(xb_ld(&bar[XB_XGEN(b.x)]) == gen, bar);
            __builtin_amdgcn_fence(__ATOMIC_ACQUIRE, "agent");
            asm volatile("s_waitcnt vmcnt(0)" ::: "memory");
        }
    }
    __syncthreads();
}


struct Frame {
    LAS unsigned char* lds;
    volatile LAS unsigned* MISC;
    int tid, lane, wave;
    int vcu, G;
};
__device__ __forceinline__ Frame phase_frame(const Frame& F0) { Frame F = F0; int t = threadIdx.x; asm volatile("" : "+v"(t)); F.tid = t; F.lane = t & 63; F.wave = __builtin_amdgcn_readfirstlane(t >> 6); return F; }
__device__ __forceinline__ float wave_sum(float v) {
#pragma unroll
    for (int o = 1; o < 64; o <<= 1) v += __shfl_xor(v, o);
    return v;
}

__device__ __forceinline__ void p0_transpose_item(const float* W, int ldw, int src_col, int coloff  , const float* gain, bf16_t* WT, int Kd, int dst_row, int kb, LAS float* scr, int lane) {
    const int k0 = 64 * kb, c = lane & 7;
    f32x4 g0 = {1.f, 1.f, 1.f, 1.f}, g1 = g0;
    if (gain) { g0 = *(const f32x4*)(gain + k0 + 8 * c); g1 = *(const f32x4*)(gain + k0 + 8 * c + 4); }
    float v[32];
#pragma unroll
    for (int i = 0; i < 32; ++i) { const int kk = 2 * i + (lane >> 5); v[i] = W[(size_t)(k0 + kk) * ldw + src_col + coloff]; }
#pragma unroll
    for (int i = 0; i < 32; ++i) { const int kk = 2 * i + (lane >> 5); scr[kk * 33 + (lane & 31)] = v[i]; }
    LDS_WAIT(); asm volatile("" ::: "memory");
#pragma unroll
    for (int j = 0; j < 4; ++j) { const int n = (lane >> 3) + 8 * j; const LAS float* s = scr + (8 * c) * 33 + n;
        v4u o; o.x = pk2(s[0 * 33] * g0.x, s[1 * 33] * g0.y); o.y = pk2(s[2 * 33] * g0.z, s[3 * 33] * g0.w); o.z = pk2(s[4 * 33] * g1.x, s[5 * 33] * g1.y); o.w = pk2(s[6 * 33] * g1.z, s[7 * 33] * g1.w);
        *(GAS v4u*)(WT + (size_t)(dst_row + n) * Kd + k0 + 8 * c) = o; }
    LDS_WAIT(); asm volatile("" ::: "memory");
}
__device__ __forceinline__ void p0_row(const float* xrow, bf16_t* orow, float* ssrow, int lane) {
    const GAS f32x4* xr = (const GAS f32x4*)xrow + lane;
    f32x4 v[4]; float s = 0.f;
#pragma unroll
    for (int j = 0; j < 4; ++j) { v[j] = xr[64 * j]; s += (v[j].x * v[j].x + v[j].y * v[j].y) + (v[j].z * v[j].z + v[j].w * v[j].w); }
    s = wave_sum(s);
    GAS unsigned long long* o8 = (GAS unsigned long long*)orow + lane;
#pragma unroll
    for (int j = 0; j < 4; ++j) o8[64 * j] = (unsigned long long)pk2(v[j].x, v[j].y) | ((unsigned long long)pk2(v[j].z, v[j].w) << 32);
    if (lane == 0) *ssrow = s;
}

constexpr size_t W_L0_QKG = 0, W_L0_V = 6 * cfg::MiB, W_L0_O = 8 * cfg::MiB;
constexpr size_t W_L1_IN = 10 * cfg::MiB, W_L1_UQ = 13 * cfg::MiB, W_L1_UKV = 14 * cfg::MiB, W_L1_O = 15 * cfg::MiB;
constexpr size_t W_L2_QKG = 17 * cfg::MiB, W_L2_V = 21 * cfg::MiB + 512 * 1024, W_L2_O = 22 * cfg::MiB;
constexpr size_t W_L3_QKG = 24 * cfg::MiB, W_L3_V = 30 * cfg::MiB, W_L3_O = 32 * cfg::MiB;
constexpr size_t W_L1_UKA = 36 * cfg::MiB;
constexpr size_t W_L1_UK = 37 * cfg::MiB;

struct Args { const float* in[22]; float* out; unsigned char* ws; int ph_lo, ph_hi, li, pad; };

__device__ __forceinline__ void p0_prologue(const Frame& F, const Args& A) {
    using namespace cfg;
    unsigned char* ws = A.ws;
    LAS float* scr = (LAS float*)(F.lds + RING_OFF + F.wave * 16384);
    const int gw = F.vcu * NWAVES + F.wave, NGW = F.G * NWAVES;
    constexpr int NITEMS = 2 * 2560 + 1568 + 1792 + 64;
    for (int it = gw; it < NITEMS; it += NGW) {
        int r = it; bool found = false;
        const float* W = nullptr; const float* gain = nullptr; bf16_t* dst = nullptr; int ldw = 0, src0 = 0, row0 = 0, Kd = 0, perm = 0, ng = 1;
#define SEG(IN, GAIN, LDW, SRC, NG, DST, ROW0, KK, KD, PERM) { constexpr int n_ = (NG) * ((KK) / 64); \
        if (!found) { if (r < n_) { W = A.in[IN]; gain = ((GAIN) >= 0) ? A.in[(GAIN) < 0 ? 0 : (GAIN)] : nullptr; ldw = (LDW); src0 = (SRC); dst = (bf16_t*)(ws + WS_W + (DST)); row0 = (ROW0); Kd = (KD); perm = (PERM); ng = (NG); found = true; } else r -= n_; } }
        SEG(2, 1, 4096, 0, 64, W_L0_QKG, 0, 1024, 1024, 0)
        SEG(2, 1, 4096, 3072, 32, W_L0_QKG, 2048, 1024, 1024, 0)
        SEG(2, 1, 4096, 2048, 32, W_L0_V, 0, 1024, 1024, 0)
        SEG(3, -1, 1024, 0, 32, W_L0_O, 0, 1024, 1024, 0)
        SEG(5, 4, 1472, 0, 8, W_L1_IN, 0, 1024, 1024, 0)
        SEG(5, 4, 1472, 448, 32, W_L1_IN, 256, 1024, 1024, 0)
        SEG(5, 4, 1472, 256, 4, W_L1_IN, 1280, 1024, 1024, 0)
        SEG(5, 4, 1472, 384, 2, W_L1_IN, 1408, 1024, 1024, 3)
        SEG(7, 6, 1536, 0, 48, W_L1_UQ, 0, 256, 256, 2)
        SEG(9, 8, 2048, 0, 64, W_L1_UKV, 0, 128, 256, 0)
        SEG(9, 8, 2048, 0, 4, W_L1_UK, 0, 128, 256, 0) SEG(9, 8, 2048, 256, 4, W_L1_UK, 128, 128, 256, 0) SEG(9, 8, 2048, 512, 4, W_L1_UK, 256, 128, 256, 0) SEG(9, 8, 2048, 768, 4, W_L1_UK, 384, 128, 256, 0)
        SEG(9, 8, 2048, 1024, 4, W_L1_UK, 512, 128, 256, 0) SEG(9, 8, 2048, 1280, 4, W_L1_UK, 640, 128, 256, 0) SEG(9, 8, 2048, 1536, 4, W_L1_UK, 768, 128, 256, 0) SEG(9, 8, 2048, 1792, 4, W_L1_UK, 896, 128, 256, 0)
        SEG(12, -1, 1024, 0, 32, W_L1_O, 0, 1024, 1024, 0)
        SEG(14, 13, 2560, 0, 32, W_L2_QKG, 0, 1024, 1024, 1)
        SEG(14, 13, 2560, 1024, 8, W_L2_QKG, 1024, 1024, 1024, 1)
        SEG(14, 13, 2560, 1536, 32, W_L2_QKG, 1280, 1024, 1024, 1)
        SEG(14, 13, 2560, 1280, 8, W_L2_V, 0, 1024, 1024, 0)
        SEG(18, -1, 1024, 0, 32, W_L2_O, 0, 1024, 1024, 0)
        SEG(20, 19, 4096, 0, 64, W_L3_QKG, 0, 1024, 1024, 0)
        SEG(20, 19, 4096, 3072, 32, W_L3_QKG, 2048, 1024, 1024, 0)
        SEG(20, 19, 4096, 2048, 32, W_L3_V, 0, 1024, 1024, 0)
        SEG(21, -1, 1024, 0, 32, W_L3_O, 0, 1024, 1024, 0)
#undef SEG
        const int kb = r / ng, gi = r % ng, pg = perm == 1 ? ((gi & ~7) + 4 * (gi & 1) + ((gi & 7) >> 1)) : gi;
        const int j31 = F.lane & 31, il = (j31 >> 1) + 32 * (j31 & 1);
        int sbase = src0 + 32 * gi, coff = j31;
        if (perm == 2) { const int hd = gi / 6, gl = gi % 6; if (gl >= 4) { sbase = src0 + 192 * hd + 128 + 16 * (gl - 4); coff = il; } }
        if (perm == 3) { sbase = src0 + 16 * gi; coff = il; }
        p0_transpose_item(W, ldw, sbase, coff, gain, dst, Kd, row0 + 32 * pg, kb, scr, F.lane);
    }
    { const int gt = gw * 64 + F.lane, NGT = NGW * 64; const v4u z = {0u, 0u, 0u, 0u};
      GAS v4u* p = (GAS v4u*)(ws + WS_W + W_L1_IN + (size_t)1472 * 1024 * 2);
      for (int i = gt; i < 64 * 1024 * 2 / 16; i += NGT) p[i] = z;
      GAS v4u* q = (GAS v4u*)(ws + WS_W + W_L1_UKV);
      for (int i = gt; i < 2048 * 16; i += NGT) q[(size_t)(i >> 4) * 32 + 16 + (i & 15)] = z;
      GAS v4u* q2 = (GAS v4u*)(ws + WS_W + W_L1_UK);
      for (int i = gt; i < 1024 * 16; i += NGT) q2[(size_t)(i >> 4) * 32 + 16 + (i & 15)] = z; }
    { const int gt = gw * 64 + F.lane, NGT = NGW * 64; float* tab = (float*)(ws + WS_ROPE);
      for (int e = gt; e < S * 32; e += NGT) { const int pos = e >> 5, i = e & 31;
          const double inv = exp(-(double)i / 32.0 * 9.210340371976184), rev = (double)pos * inv * 0.15915494309189535, fr = rev - floor(rev);
          const float an = (float)(fr * 6.283185307179586); tab[2 * e] = cosf(an); tab[2 * e + 1] = sinf(an); } }
    if (gw == 0) { float* gp = (float*)(ws + WS_GPERM);
      for (int p = F.lane; p < 192; p += 64) { const int lg = p < 128 ? p : 128 + ((p - 128) >> 1) + 32 * (p & 1); gp[p] = p < 128 ? A.in[10][lg] * A.in[11][lg] : A.in[10][lg]; gp[192 + p] = A.in[11][lg]; } }
    { const int gt = gw * 64 + F.lane, NGT = NGW * 64; bf16_t* wa = (bf16_t*)(ws + WS_W + W_L1_UKA);
      for (int e = gt; e < 8 * 128 * 16; e += NGT) { const int c8 = e & 15, j = (e >> 4) & 127, hh = e >> 11;
          const float* src = A.in[9] + (size_t)j * 2048 + hh * 256 + c8 * 8; const float gj = A.in[8][j];
          const f32x4 a = *(const f32x4*)src, b2 = *(const f32x4*)(src + 4);
          v4u o; o.x = pk2(a.x * gj, a.y * gj); o.y = pk2(a.z * gj, a.w * gj); o.z = pk2(b2.x * gj, b2.y * gj); o.w = pk2(b2.z * gj, b2.w * gj);
          *(GAS v4u*)(wa + ((size_t)(hh * 128 + j) * 128 + c8 * 8)) = o; } }
    { const float* x = A.in[0]; bf16_t* xb = (bf16_t*)(ws + WS_XB); float* ss = (float*)(ws + WS_SS);
      for (int m0 = gw * 4; m0 < M; m0 += NGW * 4) {
          f32x4 v[4][4];
#pragma unroll
          for (int r = 0; r < 4; ++r) { const GAS f32x4* xr = (const GAS f32x4*)(x + (size_t)(m0 + r) * D) + F.lane;
#pragma unroll
              for (int j = 0; j < 4; ++j) v[r][j] = __builtin_nontemporal_load(xr + 64 * j); }
#pragma unroll
          for (int r = 0; r < 4; ++r) { float sq = 0.f;
#pragma unroll
              for (int j = 0; j < 4; ++j) sq += (v[r][j].x * v[r][j].x + v[r][j].y * v[r][j].y) + (v[r][j].z * v[r][j].z + v[r][j].w * v[r][j].w);
              sq = wave_sum(sq);
              GAS unsigned long long* o8 = (GAS unsigned long long*)(xb + (size_t)(m0 + r) * D) + F.lane;
#pragma unroll
              for (int j = 0; j < 4; ++j) o8[64 * j] = (unsigned long long)pk2(v[r][j].x, v[r][j].y) | ((unsigned long long)pk2(v[r][j].z, v[r][j].w) << 32);
              if (F.lane == 0) ss[m0 + r] = sq; } } }
}

__device__ __forceinline__ void mla_prep(const Frame& F, const Args& A) {
    using namespace cfg;
    unsigned char* ws = A.ws;
    const bf16_t* KV2 = (const bf16_t*)(ws + WS_KV2); bf16_t* KR = (bf16_t*)(ws + WS_KR); const float* tab = (const float*)(ws + WS_ROPE); const float* gk = (const float*)(ws + WS_GPERM) + 192 + 128;
    const float* ssn = (const float*)(ws + WS_SSN); float* rk = (float*)(ws + WS_RK);
    const float* sskv = (const float*)(ws + WS_SSKV); bf16_t* KVN = (bf16_t*)(ws + WS_KVN);
    const int gw = F.vcu * NWAVES + F.wave, NGW = F.G * NWAVES, lane = F.lane;
    const float g = gk[lane];
    for (int row0 = gw * 4; row0 < M; row0 += NGW * 4) {
        float kp[4], sn[4];
#pragma unroll
        for (int r = 0; r < 4; ++r) { kp[r] = bf2f(KV2[(size_t)(row0 + r) * 256 + 128 + lane]); sn[r] = 0.f; if (lane < 8) { const f32x4 s4 = *(const f32x4*)(ssn + ((size_t)(row0 + r) * 8 + lane) * 4); sn[r] = (s4.x + s4.y) + (s4.z + s4.w); } }
#pragma unroll
        for (int r = 0; r < 4; ++r) { const int row = row0 + r, pos = row & (S - 1);
            const float sspe = wave_sum(kp[r] * kp[r]);
            if (lane < 8) rk[(size_t)((row >> 12) * 8 + lane) * S + pos] = __builtin_amdgcn_rsqf((sn[r] + sspe) * (1.0f / 192.0f) + NORM_EPS);
            const float x = kp[r] * g, xp = __shfl_xor(x, 1);
            const float cs = tab[(size_t)(pos * 32 + (lane >> 1)) * 2], sn_ = tab[(size_t)(pos * 32 + (lane >> 1)) * 2 + 1];
            const float o = (lane & 1) ? x * cs + xp * sn_ : x * cs - xp * sn_;
            KR[(size_t)row * 64 + lane] = f2bf(o);
        }
        { const int row = row0 + (lane >> 4), c = (lane & 15) * 8;
          const f32x4 s4 = *(const f32x4*)(sskv + (size_t)row * 4); const float rkv = __builtin_amdgcn_rsqf(((s4.x + s4.y) + (s4.z + s4.w)) * (1.0f / 128.0f) + NORM_EPS);
          const v4u w = *(const v4u*)(KV2 + (size_t)row * 256 + c); v4u o4;
          o4.x = pk2(__uint_as_float(w.x << 16) * rkv, __uint_as_float(w.x & 0xffff0000u) * rkv); o4.y = pk2(__uint_as_float(w.y << 16) * rkv, __uint_as_float(w.y & 0xffff0000u) * rkv);
          o4.z = pk2(__uint_as_float(w.z << 16) * rkv, __uint_as_float(w.z & 0xffff0000u) * rkv); o4.w = pk2(__uint_as_float(w.w << 16) * rkv, __uint_as_float(w.w & 0xffff0000u) * rkv);
          *(v4u*)(KVN + (size_t)row * 128 + c) = o4; }
    }
}

namespace att {
typedef short bf16x8 __attribute__((ext_vector_type(8)));
typedef float f32x16 __attribute__((ext_vector_type(16)));
typedef float f32x4 __attribute__((ext_vector_type(4)));
typedef unsigned u32x4 __attribute__((ext_vector_type(4)));
__device__ __forceinline__ unsigned cvtpk(float lo, float hi) { unsigned r; asm volatile("v_cvt_pk_bf16_f32 %0, %1, %2" : "=v"(r) : "v"(lo), "v"(hi)); return r; }
__device__ __forceinline__ int crow(int r, int hi) { return (r & 3) + 8 * (r >> 2) + 4 * hi; }
__device__ __forceinline__ float x32_sum(float x) { const auto rr = __builtin_amdgcn_permlane32_swap(__float_as_uint(x), __float_as_uint(x), false, false); return __uint_as_float(rr[0]) + __uint_as_float(rr[1]); }
__device__ __forceinline__ float x32_max(float x) { const auto rr = __builtin_amdgcn_permlane32_swap(__float_as_uint(x), __float_as_uint(x), false, false); return fmaxf(__uint_as_float(rr[0]), __uint_as_float(rr[1])); }
__device__ __forceinline__ float x32_other(float x, int hi) { const auto rr = __builtin_amdgcn_permlane32_swap(__float_as_uint(x), __float_as_uint(x), false, false); return __uint_as_float(hi ? rr[0] : rr[1]); }
__device__ __forceinline__ float silu(float g) { return g * __builtin_amdgcn_rcpf(1.0f + __builtin_amdgcn_exp2f(-g * cfg::LOG2E)); }

constexpr int STG_ROW = 144, STG_BYTES = 32 * STG_ROW;
typedef unsigned u32x2 __attribute__((ext_vector_type(2)));
__device__ __forceinline__ void stage_gate_in(LAS unsigned char* stg, const bf16_t* Grow0  , int lane_) {
    int lane = lane_; asm volatile("" : "+v"(lane));
#pragma unroll
    for (int i = 0; i < 4; ++i) { const int row = 8 * i + (lane >> 3), ch = lane & 7;
        const u32x4 v = *(const u32x4*)(Grow0 + (size_t)row * 1024 + ch * 8); *(LAS u32x4*)(stg + row * STG_ROW + ch * 16) = v; }
}
__device__ __forceinline__ void stage_gated_out(LAS unsigned char* stg, const f32x16& ot0, const f32x16& ot1, bf16_t* Orow0, int lane_) {
    int lane = lane_; asm volatile("" : "+v"(lane));
    const int q = lane & 31, hi = lane >> 5;
#pragma unroll
    for (int nb = 0; nb < 2; ++nb)
#pragma unroll
        for (int g = 0; g < 4; ++g) { LAS u32x2* p = (LAS u32x2*)(stg + q * STG_ROW + (32 * nb + 8 * g + 4 * hi) * 2);
            const u32x2 gv = *p; const f32x16& o = nb ? ot1 : ot0;
            const float g0 = __uint_as_float(gv.x << 16), g1 = __uint_as_float(gv.x & 0xffff0000u), g2 = __uint_as_float(gv.y << 16), g3 = __uint_as_float(gv.y & 0xffff0000u);
            u32x2 w; w.x = cvtpk(o[4 * g] * silu(g0), o[4 * g + 1] * silu(g1)); w.y = cvtpk(o[4 * g + 2] * silu(g2), o[4 * g + 3] * silu(g3));
            *p = w; }
#pragma unroll
    for (int i = 0; i < 4; ++i) { const int row = 8 * i + (lane >> 3), ch = lane & 7;
        const u32x4 v = *(const LAS u32x4*)(stg + row * STG_ROW + ch * 16); *(u32x4*)(Orow0 + (size_t)row * 1024 + ch * 8) = v; }
}

__device__ __forceinline__ void sb_attn_phase(const Frame& F, const bf16_t* Q, const bf16_t* __restrict__ Kt, const bf16_t* __restrict__ Vtt, const bf16_t* __restrict__ G, bf16_t* OG) {
    using namespace cfg;
    const int lane = F.lane, r32 = lane & 31, hi = lane >> 5;
    for (int idx = F.vcu; idx < B * 16 * 16; idx += F.G) {
        const int bh0 = idx >> 4, b = bh0 >> 4, qb = (idx & 15) ^ (int)((0x96C3A5F0u >> (4 * (b & 7))) & 15u), h = ((bh0 & 15) + b) & 15, bh = b * 16 + h;
        const int t0 = qb * 256 + F.wave * 32;
        bf16x8 qf[4];
        { const bf16_t* Qp = Q + (size_t)(b * S + t0 + r32) * 1024 + h * 64 + hi * 8;
#pragma unroll
          for (int d0 = 0; d0 < 4; ++d0) qf[d0] = *(const bf16x8*)(Qp + d0 * 16); }
        const bf16x8* Kf = (const bf16x8*)Kt + (size_t)bh * (128 * 4 * 64) + lane;
        const bf16x8* Vf = (const bf16x8*)Vtt + (size_t)bh * (128 * 4 * 64) + lane;
        LAS unsigned char* stg = F.lds + RING_OFF + F.wave * STG_BYTES;
        stage_gate_in(stg, G + (size_t)(b * S + t0) * 1024 + h * 64, lane);
        f32x16 o0 = {}, o1 = {};
        float R = 1.0f;
        const int kbd = t0 >> 5;
        bf16x8 ka[4], va[4], kb_[4], vb_[4], kc[4], vc[4], kd[4], vd[4];
#define SB_LOAD(KS, VS, kbx) do { if ((kbx) >= 0) { _Pragma("unroll") for (int i_ = 0; i_ < 4; ++i_) { KS[i_] = Kf[((kbx) * 4 + i_) * 64]; VS[i_] = Vf[((kbx) * 4 + i_) * 64]; } } } while (0)
#define SB_BODY(KS, VS, DIAG) do { \
            f32x16 p = {}; \
            _Pragma("unroll") for (int d0 = 0; d0 < 4; ++d0) p = __builtin_amdgcn_mfma_f32_32x32x16_bf16(KS[d0], qf[d0], p, 0, 0, 0); \
            float w[16]; \
            _Pragma("unroll") for (int r = 0; r < 16; ++r) { float ev = __builtin_amdgcn_exp2f(p[r]); \
                if ((DIAG) && (16 * hi + r >= r32)) ev = 0.f;                         \
                w[r] = __builtin_amdgcn_rcpf(1.0f + ev); } \
            const float T = (((w[0] * w[1]) * (w[2] * w[3])) * ((w[4] * w[5]) * (w[6] * w[7]))) * (((w[8] * w[9]) * (w[10] * w[11])) * ((w[12] * w[13]) * (w[14] * w[15]))); \
            const float To = x32_other(T, hi); \
            float c = hi == 0 ? R * To : R; \
            float a[16]; \
            _Pragma("unroll") for (int r = 15; r >= 0; --r) { const float cn = c * w[r]; a[r] = c - cn; c = cn; } \
            R = R * (T * To); \
            u32x4 w0, w1; \
            w0.x = cvtpk(a[0], a[1]); w0.y = cvtpk(a[2], a[3]); w0.z = cvtpk(a[4], a[5]); w0.w = cvtpk(a[6], a[7]); \
            w1.x = cvtpk(a[8], a[9]); w1.y = cvtpk(a[10], a[11]); w1.z = cvtpk(a[12], a[13]); w1.w = cvtpk(a[14], a[15]); \
            const bf16x8 pf0 = __builtin_bit_cast(bf16x8, w0), pf1 = __builtin_bit_cast(bf16x8, w1); \
            o0 = __builtin_amdgcn_mfma_f32_32x32x16_bf16(VS[0], pf0, o0, 0, 0, 0);     \
            o0 = __builtin_amdgcn_mfma_f32_32x32x16_bf16(VS[1], pf1, o0, 0, 0, 0); \
            o1 = __builtin_amdgcn_mfma_f32_32x32x16_bf16(VS[2], pf0, o1, 0, 0, 0); \
            o1 = __builtin_amdgcn_mfma_f32_32x32x16_bf16(VS[3], pf1, o1, 0, 0, 0); } while (0)
        SB_LOAD(ka, va, kbd); SB_LOAD(kb_, vb_, kbd - 1); SB_LOAD(kc, vc, kbd - 2); SB_LOAD(kd, vd, kbd - 3);
        for (int kb = kbd; kb >= 0; kb -= 4) {
            SB_BODY(ka, va, kb == kbd); SB_LOAD(ka, va, kb - 4);
            if (kb - 1 < 0 || __all(R == 0.0f)) break;
            SB_BODY(kb_, vb_, false); SB_LOAD(kb_, vb_, kb - 5);
            if (kb - 2 < 0 || __all(R == 0.0f)) break;
            SB_BODY(kc, vc, false); SB_LOAD(kc, vc, kb - 6);
            if (kb - 3 < 0 || __all(R == 0.0f)) break;
            SB_BODY(kd, vd, false); SB_LOAD(kd, vd, kb - 7);
            if (__all(R == 0.0f)) break;
        }
#undef SB_LOAD
#undef SB_BODY
        stage_gated_out(stg, o0, o1, OG + (size_t)(b * S + t0) * 1024 + h * 64, lane);
    }
}

__device__ __forceinline__ void swa_attn_phase(const Frame& F, const bf16_t* Q, const bf16_t* __restrict__ Kt, const bf16_t* __restrict__ Vtt, const bf16_t* __restrict__ G, const float* __restrict__ sinks, bf16_t* OG) {
    using namespace cfg;
    const int lane = F.lane, r32 = lane & 31, hi = lane >> 5;
    for (int idx = F.vcu; idx < B * 4 * 64; idx += F.G) {
        const int b = idx >> 8, kvh = (idx >> 6) & 3, rb = idx & 63;
        const int h = kvh * 4 + (F.wave & 3), t0 = rb * 64 + (F.wave >> 2) * 32;
        const float slope2 = __builtin_amdgcn_exp2f(-0.5f * (float)(h + 1)) * LOG2E, sink2 = sinks[h] * LOG2E;
        bf16x8 qf[4];
        { const bf16_t* Qp = Q + (size_t)(b * S + t0 + r32) * 1024 + h * 64 + hi * 8;
#pragma unroll
          for (int d0 = 0; d0 < 4; ++d0) qf[d0] = *(const bf16x8*)(Qp + d0 * 16); }
        LAS unsigned char* stg = F.lds + RING_OFF + F.wave * STG_BYTES;
        stage_gate_in(stg, G + (size_t)(b * S + t0) * 1024 + h * 64, lane);
        const int kb0 = (t0 >> 5) - 4;
        const bf16x8* Kf = (const bf16x8*)Kt + (size_t)(b * 4 + kvh) * (128 * 4 * 64) + lane;
        const bf16x8* Vf = (const bf16x8*)Vtt + (size_t)(b * 4 + kvh) * (128 * 4 * 64) + lane;
        bf16x8 kf[5][4];
#pragma unroll
        for (int i = 0; i < 5; ++i) { const int kbi = kb0 + i < 0 ? 0 : kb0 + i;
#pragma unroll
            for (int d0 = 0; d0 < 4; ++d0) kf[i][d0] = Kf[(kbi * 4 + d0) * 64]; }
        f32x16 p[5];
#pragma unroll
        for (int i = 0; i < 5; ++i) { f32x16 acc = {};
#pragma unroll
            for (int d0 = 0; d0 < 4; ++d0) acc = __builtin_amdgcn_mfma_f32_32x32x16_bf16(kf[i][d0], qf[d0], acc, 0, 0, 0);
            p[i] = acc; }
        __builtin_amdgcn_sched_barrier(0);
        bf16x8 vf[5][4];
#pragma unroll
        for (int i = 0; i < 5; ++i) { const int kbi = kb0 + i < 0 ? 0 : kb0 + i;
#pragma unroll
            for (int f = 0; f < 4; ++f) vf[i][f] = Vf[(kbi * 4 + f) * 64]; }
        __builtin_amdgcn_sched_barrier(0);
        int rl = r32 - 16 * hi; asm volatile("" : "+v"(rl));
        const float srl = slope2 * (float)rl;
        float mx = sink2, mxb = -INFINITY;
#pragma unroll
        for (int i = 0; i < 5; ++i) { const bool exists = kb0 + i >= 0;
            const float ci = exists ? fmaf(slope2, (float)(128 - 32 * i), srl) : INFINITY;
#pragma unroll
            for (int r = 0; r < 16; ++r) { float v = (p[i][r] + slope2 * (float)r) - ci;
                if (i == 0) { if (r <= rl) v = -INFINITY; }
                if (i == 4) { if (r > rl) v = -INFINITY; }
                p[i][r] = v; }
#pragma unroll
            for (int r = 0; r < 16; r += 4) { asm("v_max3_f32 %0, %1, %2, %3" : "=v"(mx) : "v"(mx), "v"(p[i][r]), "v"(p[i][r + 1])); asm("v_max3_f32 %0, %1, %2, %3" : "=v"(mxb) : "v"(mxb), "v"(p[i][r + 2]), "v"(p[i][r + 3])); } }
        asm("v_max_f32 %0, %1, %2" : "=v"(mx) : "v"(mx), "v"(mxb));
        { const float mo = x32_other(mx, hi); asm("v_max_f32 %0, %1, %2" : "=v"(mx) : "v"(mx), "v"(mo)); }
        float sum = 0.f;
#pragma unroll
        for (int i = 0; i < 5; ++i)
#pragma unroll
            for (int r = 0; r < 16; ++r) { const float ev = __builtin_amdgcn_exp2f(p[i][r] - mx); p[i][r] = ev; sum += ev; }
        sum = x32_sum(sum);
        const float inv = __builtin_amdgcn_rcpf(sum + __builtin_amdgcn_exp2f(sink2 - mx));
        f32x16 o0 = {}, o1 = {};
#pragma unroll
        for (int i = 0; i < 5; ++i) { u32x4 w0, w1;
            w0.x = cvtpk(p[i][0], p[i][1]); w0.y = cvtpk(p[i][2], p[i][3]); w0.z = cvtpk(p[i][4], p[i][5]); w0.w = cvtpk(p[i][6], p[i][7]);
            w1.x = cvtpk(p[i][8], p[i][9]); w1.y = cvtpk(p[i][10], p[i][11]); w1.z = cvtpk(p[i][12], p[i][13]); w1.w = cvtpk(p[i][14], p[i][15]);
            const bf16x8 pf0 = __builtin_bit_cast(bf16x8, w0), pf1 = __builtin_bit_cast(bf16x8, w1);
            o0 = __builtin_amdgcn_mfma_f32_32x32x16_bf16(vf[i][0], pf0, o0, 0, 0, 0);
            o0 = __builtin_amdgcn_mfma_f32_32x32x16_bf16(vf[i][1], pf1, o0, 0, 0, 0);
            o1 = __builtin_amdgcn_mfma_f32_32x32x16_bf16(vf[i][2], pf0, o1, 0, 0, 0);
            o1 = __builtin_amdgcn_mfma_f32_32x32x16_bf16(vf[i][3], pf1, o1, 0, 0, 0); }
#pragma unroll
        for (int r = 0; r < 16; ++r) { o0[r] *= inv; o1[r] *= inv; }
        stage_gated_out(stg, o0, o1, OG + (size_t)(b * S + t0) * 1024 + h * 64, lane);
    }
}

constexpr int MLA_RK = 160768;
constexpr int MLA_KB = 24576, MLA_VB = 16384, MLA_V0 = 0, MLA_K0 = 3 * MLA_VB, MLA_WS = MLA_K0 + 3 * MLA_KB;
typedef short v4i16_t __attribute__((ext_vector_type(4)));
__device__ __forceinline__ v4i16_t vtr(const LAS unsigned char* p) { return __builtin_amdgcn_ds_read_tr16_b64_v4i16((LAS v4i16_t*)p); }
__device__ __forceinline__ int swap23(int k) { return (k & ~0xC) | ((k & 4) << 1) | ((k & 8) >> 1); }
#define MLA_BAR() asm volatile("s_waitcnt vmcnt(0) lgkmcnt(0)\n\ts_barrier" ::: "memory")
#define SBAR() __builtin_amdgcn_sched_barrier(0)

__device__ __forceinline__ void mla_attn_phase(const Frame& F, const bf16_t* __restrict__ Qm, const bf16_t* Gin, bf16_t* Gout, const unsigned char* ws_) {
    using namespace cfg;
    const int lane = F.lane, r32 = lane & 31, hi = lane >> 5, wave = F.wave;
    const bool halfB = wave >= 4;
    LAS unsigned char* lds = F.lds + RING_OFF;
    const int nun = 2 * ((512 - F.vcu + F.G - 1) / F.G);
#define MLA_COORDS(k_, b_, h_, qb_) const int it_##b_ = F.vcu + ((k_) >> 1) * F.G, b_ = it_##b_ >> 6, h_ = (it_##b_ >> 3) & 7, qb_ = ((k_) & 1) ? (it_##b_ & 7) : 15 - (it_##b_ & 7)
    const __amdgpu_buffer_rsrc_t rW = __builtin_amdgcn_make_buffer_rsrc((void*)ws_, 0, 0x7ffffff0, 0x00020000);
    unsigned koffN, koffP, voff, rbase;
#define MLA_OFFS(b_, h_) do { { const int row = 8 * wave + (lane >> 3), c = (lane & 7) ^ ((row >> 1) & 7); \
      koffN = (unsigned)WS_KVN + (unsigned)(((b_) * S + row) * 128 + c * 8) * 2u; koffP = (unsigned)WS_KR + (unsigned)(((b_) * S + row) * 64 + c * 8) * 2u; } \
    { const int kk = (wave << 3) | ((lane >> 2) & 7), c8 = ((lane >> 5) << 2) | (lane & 3); voff = (unsigned)WS_KVN + (unsigned)(((b_) * S + swap23(kk)) * 128 + c8 * 8) * 2u; }     \
    rbase = (unsigned)WS_RK + (unsigned)(((b_) * 8 + (h_)) * S) * 4u; } while (0)
#define MLA_DMA_K1(t_, buf_, i) __builtin_amdgcn_raw_ptr_buffer_load_lds(rW, (LAS void*)(lds + MLA_K0 + (buf_) * MLA_KB + (i) * 8192 + wave * 1024), 16, (i) == 2 ? koffP : koffN, \
        (i) == 2 ? (t_) * (64 * 64 * 2) : (t_) * (64 * 128 * 2) + (i) * 128, 0, 0)
#define MLA_DMA_R(t_, buf_) do { unsigned rv_ = lane; asm volatile("" : "+v"(rv_)); __builtin_amdgcn_raw_ptr_buffer_load_lds(rW, (LAS void*)(lds + MLA_RK + ((t_) & 3) * 256), 4, rv_ * 4u, rbase + (t_) * 256, 0, 0); } while (0)
#define MLA_DMA_V1(t_, buf_, i) __builtin_amdgcn_raw_ptr_buffer_load_lds(rW, (LAS void*)(lds + MLA_V0 + (buf_) * MLA_VB + (wave * 2 + (i)) * 1024), 16, voff, (t_) * (64 * 128 * 2) + (i) * 128, 0, 0)
#define MLA_DMA_K(t_, buf_) do { _Pragma("unroll") for (int i = 0; i < 3; ++i) MLA_DMA_K1(t_, buf_, i); MLA_DMA_R(t_, buf_); } while (0)
#define MLA_DMA_V(t_, buf_) do { _Pragma("unroll") for (int i = 0; i < 2; ++i) MLA_DMA_V1(t_, buf_, i); } while (0)
#define MLA_REQUEST(b_, h_, qb_) do { MLA_OFFS(b_, h_); \
      MLA_DMA_K(0, 0); MLA_DMA_V(0, 0); MLA_DMA_K(1, 1); if (halfB) { MLA_DMA_V(1, 1); }     \
      { unsigned lv_ = lane; asm volatile("" : "+v"(lv_));     \
        const unsigned wao = (unsigned)(WS_W + W_L1_UKA) + (unsigned)(((h_) * 128 + (int)(lv_ & 31u)) * 128 + (int)(lv_ >> 5) * 8) * 2u; \
        _Pragma("unroll") for (int i = 0; i < 4; ++i) __builtin_amdgcn_raw_ptr_buffer_load_lds(rW, (LAS void*)(lds + (wave < 4 ? MLA_V0 + 2 * MLA_VB + (wave * 4 + i) * 1024 : MLA_K0 + 2 * MLA_KB + ((wave - 4) * 4 + i) * 1024)), 16, wao, ((wave >> 1) * (32 * 128) + (4 * (wave & 1) + i) * 16) * 2, 0, 0); } \
      (void)(qb_); } while (0)
#define MLA_WQ_DMA(h_) do { unsigned lv_ = lane; asm volatile("" : "+v"(lv_)); \
      const unsigned wqo = (unsigned)(WS_W + W_L1_UQ) + (unsigned)(((h_) * 192 + (int)(lv_ & 31u)) * 256 + (int)(lv_ >> 5) * 8) * 2u; \
      _Pragma("unroll") for (int i = 0; i < 12; ++i) { const int p_ = wave * 12 + i; \
          __builtin_amdgcn_raw_ptr_buffer_load_lds(rW, (LAS void*)(lds + p_ * 1024), 16, wqo, ((p_ >> 4) * (32 * 256) + (p_ & 15) * 16) * 2, 0, 0); } } while (0)
#define MLA_UQ_LOAD(b_, h_, qb_) do { (void)(h_); \
      const bf16_t* Qlp = (const bf16_t*)(ws_ + WS_QL) + (size_t)((b_) * S + (qb_) * 256 + wave * 32 + r32) * 256 + hi * 8; \
      _Pragma("unroll") for (int ks = 0; ks < 16; ++ks) Bq[ks] = *(const bf16x8*)(Qlp + ks * 16); \
      s4q = *(const f32x4*)((const float*)(ws_ + WS_SSQ) + (size_t)((b_) * S + (qb_) * 256 + wave * 32 + r32) * 4); } while (0)
#define MLA_UQ(b_, h_, qb_, vm_) do { const f32x4 s4 = s4q; \
      asm volatile("s_waitcnt vmcnt(" #vm_ ") lgkmcnt(0)\n\ts_barrier" ::: "memory");     \
      const float rq = __builtin_amdgcn_rsqf(((s4.x + s4.y) + (s4.z + s4.w)) * (1.0f / 256.0f) + NORM_EPS); \
      f32x16 qa[6] = {}; bf16x8 Af[2][6]; int lf_ = lane; asm volatile("" : "+v"(lf_)); \
      _Pragma("unroll") for (int db = 0; db < 6; ++db) Af[0][db] = *(const LAS bf16x8*)(lds + (db * 16) * 1024 + lf_ * 16); \
      _Pragma("unroll") for (int ks = 0; ks < 16; ++ks) { SBAR(); \
          if (ks + 1 < 16) { _Pragma("unroll") for (int db = 0; db < 6; ++db) Af[(ks + 1) & 1][db] = *(const LAS bf16x8*)(lds + (db * 16 + ks + 1) * 1024 + lf_ * 16); } \
          _Pragma("unroll") for (int db = 0; db < 6; ++db) qa[db] = __builtin_amdgcn_mfma_f32_32x32x16_bf16(Af[ks & 1][db], Bq[ks], qa[db], 0, 0, 0); } \
      asm volatile("s_waitcnt lgkmcnt(0)\n\ts_barrier" ::: "memory");     \
      MLA_REQUEST(b_, h_, qb_); \
      _Pragma("unroll") for (int db = 0; db < 6; ++db) _Pragma("unroll") for (int g = 0; g < 2; ++g) { \
          const unsigned u0 = cvtpk(qa[db][8 * g + 0] * rq, qa[db][8 * g + 1] * rq), u1 = cvtpk(qa[db][8 * g + 2] * rq, qa[db][8 * g + 3] * rq); \
          const unsigned v0 = cvtpk(qa[db][8 * g + 4] * rq, qa[db][8 * g + 5] * rq), v1 = cvtpk(qa[db][8 * g + 6] * rq, qa[db][8 * g + 7] * rq); \
          const auto e0 = __builtin_amdgcn_permlane32_swap(u0, v0, false, false), e1 = __builtin_amdgcn_permlane32_swap(u1, v1, false, false); \
          u32x4 w; w.x = e0[0]; w.y = e1[0]; w.z = e0[1]; w.w = e1[1]; qf[2 * db + g] = __builtin_bit_cast(bf16x8, w); } } while (0)
    bf16x8 qf[12];
    bf16x8 Bq[16]; f32x4 s4q;
    MLA_BAR();
    { MLA_COORDS(0, b0_, h0_, q0_); MLA_WQ_DMA(h0_); MLA_UQ_LOAD(b0_, h0_, q0_); MLA_UQ(b0_, h0_, q0_, 0); }
    for (int k = 0; k < nun; ++k) {
    MLA_COORDS(k, b, h, qb);
    const int t0 = qb * 256 + wave * 32, NT = 4 * (qb + 1);
    { float ssq = 0.f;
#pragma unroll
      for (int d0 = 0; d0 < 12; ++d0)
#pragma unroll
          for (int j = 0; j < 8; ++j) { const float v = bf2f((bf16_t)qf[d0][j]); ssq = fmaf(v, v, ssq); }
      ssq = x32_sum(ssq);
      const float rh = __builtin_amdgcn_rsqf(ssq * (1.0f / 192.0f) + NORM_EPS) * MLA_QSCALE;
      int hio = hi; asm volatile("" : "+v"(hio));
      const float* gq = (const float*)(ws_ + WS_GPERM) + 8 * hio; const float* tb = (const float*)(ws_ + WS_ROPE) + (size_t)((t0 + r32) * 32 + 4 * hio) * 2;
#pragma unroll
      for (int d0 = 0; d0 < 12; ++d0) { const f32x4 ga = *(const f32x4*)(gq + 16 * d0), gb = *(const f32x4*)(gq + 16 * d0 + 4);
          f32x4 a = {bf2f((bf16_t)qf[d0][0]), bf2f((bf16_t)qf[d0][1]), bf2f((bf16_t)qf[d0][2]), bf2f((bf16_t)qf[d0][3])};
          f32x4 c = {bf2f((bf16_t)qf[d0][4]), bf2f((bf16_t)qf[d0][5]), bf2f((bf16_t)qf[d0][6]), bf2f((bf16_t)qf[d0][7])};
          a = a * rh * ga; c = c * rh * gb;
          if (d0 >= 8) { const f32x4 cs0 = *(const f32x4*)(tb + 16 * (d0 - 8)), cs1 = *(const f32x4*)(tb + 16 * (d0 - 8) + 4);
              const f32x4 ar = {a.x * cs0.x - a.y * cs0.y, a.y * cs0.x + a.x * cs0.y, a.z * cs0.z - a.w * cs0.w, a.w * cs0.z + a.z * cs0.w};
              const f32x4 cr = {c.x * cs1.x - c.y * cs1.y, c.y * cs1.x + c.x * cs1.y, c.z * cs1.z - c.w * cs1.w, c.w * cs1.z + c.z * cs1.w}; a = ar; c = cr; }
          u32x4 w; w.x = cvtpk(a.x, a.y); w.y = cvtpk(a.z, a.w); w.z = cvtpk(c.x, c.y); w.w = cvtpk(c.z, c.w); qf[d0] = __builtin_bit_cast(bf16x8, w); } }
    MLA_BAR();
    { f32x16 qa[4] = {};
      bf16x8 Aq[2][8];
      int lf_ = lane; asm volatile("" : "+v"(lf_));
#define UA_LD(hf_) do { _Pragma("unroll") for (int nl = 0; nl < 2; ++nl) _Pragma("unroll") for (int cs = 0; cs < 8; ++cs) \
        Aq[nl][cs] = *(const LAS bf16x8*)(lds + ((hf_) == 0 ? MLA_V0 + 2 * MLA_VB : MLA_K0 + 2 * MLA_KB) + (nl * 8 + cs) * 1024 + lf_ * 16); } while (0)
#define UA_MM(hf_) do { _Pragma("unroll") for (int nl = 0; nl < 2; ++nl) _Pragma("unroll") for (int cs = 0; cs < 8; ++cs) qa[2 * (hf_) + nl] = __builtin_amdgcn_mfma_f32_32x32x16_bf16(Aq[nl][cs], qf[cs], qa[2 * (hf_) + nl], 0, 0, 0); } while (0)
      UA_LD(0); SBAR(); UA_MM(0); SBAR(); UA_LD(1); SBAR(); UA_MM(1); SBAR();
#undef UA_LD
#undef UA_MM
#pragma unroll
      for (int jb = 0; jb < 4; ++jb)
#pragma unroll
          for (int g = 0; g < 2; ++g) {
              const unsigned u0 = cvtpk(qa[jb][8 * g + 0], qa[jb][8 * g + 1]), u1 = cvtpk(qa[jb][8 * g + 2], qa[jb][8 * g + 3]);
              const unsigned v0 = cvtpk(qa[jb][8 * g + 4], qa[jb][8 * g + 5]), v1 = cvtpk(qa[jb][8 * g + 6], qa[jb][8 * g + 7]);
              const auto e0 = __builtin_amdgcn_permlane32_swap(u0, v0, false, false), e1 = __builtin_amdgcn_permlane32_swap(u1, v1, false, false);
              u32x4 w; w.x = e0[0]; w.y = e1[0]; w.z = e0[1]; w.w = e1[1]; qf[2 * jb + g] = __builtin_bit_cast(bf16x8, w); } }
    asm volatile("s_waitcnt lgkmcnt(0)\n\ts_barrier" ::: "memory");
    if (halfB) MLA_DMA_K(2, 2);
    const int krow = swap23(r32), kx = (krow >> 1) & 7;
    int kad[4];
#pragma unroll
    for (int j = 0; j < 4; ++j) kad[j] = MLA_K0 + krow * 128 + 16 * ((2 * j + hi) ^ kx);
    const int vb0 = MLA_V0 + (((lane & 3) << 3) | (((lane >> 2) & 3) << 6) | (((lane >> 4) & 1) << 5) | (((lane >> 5) & 1) << 8));
    f32x16 o[4] = {};
    float mhat = 0.f, l = 0.f;
    f32x16 p0, p1;
    bf16x8 ka[4], kc[4];
#define MLA_KRD(dst, g_, kbo_) do { _Pragma("unroll") for (int j_ = 0; j_ < 2; ++j_) { const int d0_ = 2 * (g_) + j_; const LAS unsigned char* a_ = lds + (kbo_) + kad[d0_ & 3] + 8192 * (d0_ >> 2); \
        dst[2 * j_] = *(const LAS bf16x8*)a_; dst[2 * j_ + 1] = *(const LAS bf16x8*)(a_ + 32 * 128); } } while (0)
#define MLA_KMM(src, g_) do { _Pragma("unroll") for (int j_ = 0; j_ < 2; ++j_) { \
        p0 = __builtin_amdgcn_mfma_f32_32x32x16_bf16(src[2 * j_], qf[2 * (g_) + j_], ((g_) == 0 && j_ == 0) ? (f32x16){} : p0, 0, 0, 0); \
        p1 = __builtin_amdgcn_mfma_f32_32x32x16_bf16(src[2 * j_ + 1], qf[2 * (g_) + j_], ((g_) == 0 && j_ == 0) ? (f32x16){} : p1, 0, 0, 0); } } while (0)
#define MLA_QK(kbo_, rs_) do { SBAR(); MLA_KRD(ka, 0, kbo_); MLA_KRD(kc, 1, kbo_); SBAR(); MLA_KMM(ka, 0); SBAR(); MLA_KRD(ka, 2, kbo_); SBAR(); MLA_KMM(kc, 1); SBAR(); MLA_KRD(kc, 3, kbo_); SBAR(); \
        MLA_KMM(ka, 2); SBAR(); MLA_KRD(ka, 4, kbo_); SBAR(); MLA_KMM(kc, 3); SBAR(); MLA_KRD(kc, 5, kbo_); SBAR(); MLA_KMM(ka, 4); SBAR(); MLA_KMM(kc, 5); SBAR(); } while (0)
    { unsigned lv_ = lane; asm volatile("" : "+v"(lv_));
      const unsigned wvo = (unsigned)(WS_W + W_L1_UKV) + (unsigned)((h * 256 + 128 + (int)(lv_ & 31u)) * 256 + (int)(lv_ >> 5) * 8) * 2u;
#pragma unroll
      for (int i = 0; i < 4; ++i) __builtin_amdgcn_raw_ptr_buffer_load_lds(rW, (LAS void*)(lds + MLA_WS + (wave * 4 + i) * 1024), 16, wvo, ((wave >> 1) * (32 * 256) + (4 * (wave & 1) + i) * 16) * 2, 0, 0); }
    MLA_QK(0, 0);
    if (halfB) asm volatile("s_waitcnt lgkmcnt(0)\n\ts_barrier" ::: "memory");
    bf16x8 pa[4];
    int s0 = 0, s1 = 1, s2 = 2;
    const int nact = (t0 + 31) / 64 + 1;
    int t = 0;
    for (; t < nact; ++t) {
        { const int tk = min(t + 2 + (int)halfB, NT - 1), tv = min(t + 1 + (int)halfB, NT - 1), sk = halfB ? s0 : s2, sv = halfB ? s2 : s1;
          MLA_DMA_K1(tk, sk, 0); MLA_DMA_K1(tk, sk, 1); MLA_DMA_K1(tk, sk, 2); MLA_DMA_R(tk, sk); MLA_DMA_V1(tv, sv, 0); MLA_DMA_V1(tv, sv, 1); }
        {
            { const LAS float* rl_ = (const LAS float*)(lds + MLA_RK + (t & 3) * 256) + 8 * hi;
#pragma unroll
              for (int j_ = 0; j_ < 2; ++j_) { const f32x4 a_ = *(const LAS f32x4*)(rl_ + 16 * j_), b_ = *(const LAS f32x4*)(rl_ + 16 * j_ + 4), c_ = *(const LAS f32x4*)(rl_ + 32 + 16 * j_), d_ = *(const LAS f32x4*)(rl_ + 32 + 16 * j_ + 4);
#pragma unroll
                  for (int e_ = 0; e_ < 4; ++e_) {
                      asm("v_fma_f32 %0, %1, %2, -%3" : "=v"(p0[8 * j_ + e_]) : "v"(p0[8 * j_ + e_]), "v"(a_[e_]), "v"(mhat)); asm("v_fma_f32 %0, %1, %2, -%3" : "=v"(p0[8 * j_ + 4 + e_]) : "v"(p0[8 * j_ + 4 + e_]), "v"(b_[e_]), "v"(mhat));
                      asm("v_fma_f32 %0, %1, %2, -%3" : "=v"(p1[8 * j_ + e_]) : "v"(p1[8 * j_ + e_]), "v"(c_[e_]), "v"(mhat)); asm("v_fma_f32 %0, %1, %2, -%3" : "=v"(p1[8 * j_ + 4 + e_]) : "v"(p1[8 * j_ + 4 + e_]), "v"(d_[e_]), "v"(mhat)); } } }
            if (64 * t + 63 > t0) {
                const int lim = t0 + r32 - 64 * t - 8 * hi;
#pragma unroll
                for (int r = 0; r < 16; ++r) { const int ko = 16 * (r >> 3) + (r & 7); if (ko > lim) p0[r] = -INFINITY; if (ko + 32 > lim) p1[r] = -INFINITY; } }
            float pmax, pmb;
            asm("v_max3_f32 %0, %1, %2, %3" : "=v"(pmax) : "v"(p0[0]), "v"(p0[1]), "v"(p0[2])); asm("v_max3_f32 %0, %1, %2, %3" : "=v"(pmb) : "v"(p1[0]), "v"(p1[1]), "v"(p1[2]));
#pragma unroll
            for (int r = 3; r < 15; r += 2) { asm("v_max3_f32 %0, %1, %2, %3" : "=v"(pmax) : "v"(pmax), "v"(p0[r]), "v"(p0[r + 1])); asm("v_max3_f32 %0, %1, %2, %3" : "=v"(pmb) : "v"(pmb), "v"(p1[r]), "v"(p1[r + 1])); }
            asm("v_max3_f32 %0, %1, %2, %3" : "=v"(pmax) : "v"(pmax), "v"(p0[15]), "v"(p1[15])); asm("v_max_f32 %0, %1, %2" : "=v"(pmax) : "v"(pmax), "v"(pmb));
            { const float po = x32_other(pmax, hi); asm("v_max_f32 %0, %1, %2" : "=v"(pmax) : "v"(pmax), "v"(po)); }
            if (t == 0 || __any(pmax > 8.0f)) {
                const float d = t == 0 ? pmax : fmaxf(pmax, 0.f);
                if (t != 0) { const float f = __builtin_amdgcn_exp2f(-d); l *= f;
#pragma unroll
                    for (int nb = 0; nb < 4; ++nb)
#pragma unroll
                        for (int r = 0; r < 16; ++r) o[nb][r] *= f; }
                mhat += d;
#pragma unroll
                for (int r = 0; r < 16; ++r) { p0[r] -= d; p1[r] -= d; }
            }
            float ps = 0.f;
#pragma unroll
            for (int r = 0; r < 16; ++r) { p0[r] = __builtin_amdgcn_exp2f(p0[r]); p1[r] = __builtin_amdgcn_exp2f(p1[r]); ps += p0[r] + p1[r]; }
            l += ps; asm volatile("" : "+v"(l));
            u32x4 w;
            w.x = cvtpk(p0[0], p0[1]); w.y = cvtpk(p0[2], p0[3]); w.z = cvtpk(p0[4], p0[5]); w.w = cvtpk(p0[6], p0[7]); pa[0] = __builtin_bit_cast(bf16x8, w);
            w.x = cvtpk(p0[8], p0[9]); w.y = cvtpk(p0[10], p0[11]); w.z = cvtpk(p0[12], p0[13]); w.w = cvtpk(p0[14], p0[15]); pa[1] = __builtin_bit_cast(bf16x8, w);
            w.x = cvtpk(p1[0], p1[1]); w.y = cvtpk(p1[2], p1[3]); w.z = cvtpk(p1[4], p1[5]); w.w = cvtpk(p1[6], p1[7]); pa[2] = __builtin_bit_cast(bf16x8, w);
            w.x = cvtpk(p1[8], p1[9]); w.y = cvtpk(p1[10], p1[11]); w.z = cvtpk(p1[12], p1[13]); w.w = cvtpk(p1[14], p1[15]); pa[3] = __builtin_bit_cast(bf16x8, w);
        }
        if (halfB) asm volatile("s_waitcnt lgkmcnt(0)\n\ts_barrier" ::: "memory");
        else asm volatile("s_waitcnt vmcnt(6) lgkmcnt(0)\n\ts_barrier" ::: "memory");
        __builtin_amdgcn_s_setprio(1);
        {
            const int vbo = s0 * MLA_VB;
            bf16x8 va[4], vc[4];
#define MLA_VRD(dst, nb_) do { const LAS unsigned char* vp_ = lds + vbo + vb0 + (nb_) * 512; _Pragma("unroll") for (int ks = 0; ks < 4; ++ks) { const v4i16_t lo_ = vtr(vp_ + ks * 4096), hh_ = vtr(vp_ + ks * 4096 + 2048); \
                dst[ks] = (bf16x8){lo_[0], lo_[1], lo_[2], lo_[3], hh_[0], hh_[1], hh_[2], hh_[3]}; } } while (0)
#define MLA_VMM(src, nb_) do { _Pragma("unroll") for (int ks = 0; ks < 4; ++ks) o[nb_] = __builtin_amdgcn_mfma_f32_32x32x16_bf16(src[ks], pa[ks], o[nb_], 0, 0, 0); } while (0)
            SBAR(); MLA_VRD(va, 0); MLA_VRD(vc, 1); SBAR();
            MLA_VMM(va, 0); SBAR(); MLA_VRD(va, 2); SBAR();
            MLA_VMM(vc, 1); SBAR(); MLA_VRD(vc, 3); SBAR();
            MLA_VMM(va, 2); SBAR();
            MLA_VMM(vc, 3); SBAR();
#undef MLA_VRD
#undef MLA_VMM
        }
        { const int kbo = s1 * MLA_KB;
            SBAR(); MLA_KRD(ka, 0, kbo); MLA_KRD(kc, 1, kbo); SBAR(); MLA_KMM(ka, 0); SBAR(); MLA_KRD(ka, 2, kbo); SBAR(); MLA_KMM(kc, 1); SBAR(); MLA_KRD(kc, 3, kbo); SBAR();
            MLA_KMM(ka, 2); SBAR(); MLA_KRD(ka, 4, kbo); SBAR(); MLA_KMM(kc, 3); SBAR(); MLA_KRD(kc, 5, kbo); SBAR(); MLA_KMM(ka, 4); SBAR(); MLA_KMM(kc, 5); SBAR(); }
        __builtin_amdgcn_s_setprio(0);
        if (halfB && t == NT - 1) asm volatile("s_waitcnt vmcnt(0)" ::: "memory");
        if (!halfB) asm volatile("s_waitcnt lgkmcnt(0)\n\ts_barrier" ::: "memory");
        else asm volatile("s_waitcnt vmcnt(6) lgkmcnt(0)\n\ts_barrier" ::: "memory");
        { const int tmp = s0; s0 = s1; s1 = s2; s2 = tmp; }
    }
    for (; t < NT; ++t) {
        { const int tk = min(t + 2 + (int)halfB, NT - 1), tv = min(t + 1 + (int)halfB, NT - 1), sk = halfB ? s0 : s2, sv = halfB ? s2 : s1;
          MLA_DMA_K1(tk, sk, 0); MLA_DMA_K1(tk, sk, 1); MLA_DMA_K1(tk, sk, 2); MLA_DMA_R(tk, sk); MLA_DMA_V1(tv, sv, 0); MLA_DMA_V1(tv, sv, 1); }
        if (halfB) asm volatile("s_waitcnt lgkmcnt(0)\n\ts_barrier" ::: "memory");
        else asm volatile("s_waitcnt vmcnt(6) lgkmcnt(0)\n\ts_barrier" ::: "memory");
        if (halfB && t == NT - 1) asm volatile("s_waitcnt vmcnt(0)" ::: "memory");
        if (!halfB) asm volatile("s_waitcnt lgkmcnt(0)\n\ts_barrier" ::: "memory");
        else asm volatile("s_waitcnt vmcnt(6) lgkmcnt(0)\n\ts_barrier" ::: "memory");
        { const int tmp = s0; s0 = s1; s1 = s2; s2 = tmp; }
    }
    if (!halfB) MLA_BAR();
    if (k + 1 < nun) { MLA_COORDS(k + 1, bw_, hw_, qw_); (void)bw_; (void)qw_; MLA_WQ_DMA(hw_); }
#undef MLA_KRD
#undef MLA_KMM
#undef MLA_QK
    l = x32_sum(l);
    const float il = __builtin_amdgcn_rcpf(l);
    LAS unsigned char* stg = lds + MLA_WS + wave * STG_BYTES;
    const size_t go = (size_t)(b * S + t0) * 1024 + h * 128;
    bf16x8 Bo[8];
#pragma unroll
    for (int nb = 0; nb < 4; ++nb)
#pragma unroll
        for (int g = 0; g < 2; ++g) {
            const unsigned u0 = cvtpk(o[nb][8 * g + 0] * il, o[nb][8 * g + 1] * il), u1 = cvtpk(o[nb][8 * g + 2] * il, o[nb][8 * g + 3] * il);
            const unsigned v0 = cvtpk(o[nb][8 * g + 4] * il, o[nb][8 * g + 5] * il), v1 = cvtpk(o[nb][8 * g + 6] * il, o[nb][8 * g + 7] * il);
            const auto e0 = __builtin_amdgcn_permlane32_swap(u0, v0, false, false), e1 = __builtin_amdgcn_permlane32_swap(u1, v1, false, false);
            u32x4 w; w.x = e0[0]; w.y = e1[0]; w.z = e0[1]; w.w = e1[1]; Bo[2 * nb + g] = __builtin_bit_cast(bf16x8, w); }
    u32x4 gv[2][4];
    f32x16 o2[4] = {};
    { bf16x8 Aw[2][8];
      int lf_ = lane; asm volatile("" : "+v"(lf_));
#define UV_LD(hf_) do { _Pragma("unroll") for (int nl = 0; nl < 2; ++nl) _Pragma("unroll") for (int ks = 0; ks < 8; ++ks) Aw[nl][ks] = *(const LAS bf16x8*)(lds + MLA_WS + ((2 * (hf_) + nl) * 8 + ks) * 1024 + lf_ * 16); } while (0)
#define UV_MM(hf_) do { _Pragma("unroll") for (int nl = 0; nl < 2; ++nl) _Pragma("unroll") for (int ks = 0; ks < 8; ++ks) o2[2 * (hf_) + nl] = __builtin_amdgcn_mfma_f32_32x32x16_bf16(Aw[nl][ks], Bo[ks], o2[2 * (hf_) + nl], 0, 0, 0); } while (0)
#define UV_GATE(hf_) do { int lo_ = lane; asm volatile("" : "+v"(lo_)); _Pragma("unroll") for (int i = 0; i < 4; ++i) gv[hf_][i] = *(const u32x4*)(Gin + go + 64 * (hf_) + (size_t)(8 * i + (lo_ >> 3)) * 1024 + (lo_ & 7) * 8); } while (0)
      UV_GATE(0); SBAR(); UV_LD(0); SBAR(); UV_MM(0); SBAR(); UV_LD(1); SBAR(); UV_MM(1); SBAR(); UV_GATE(1); SBAR();
      asm volatile("s_waitcnt lgkmcnt(0)\n\ts_barrier" ::: "memory");
#undef UV_GATE
#undef UV_LD
#undef UV_MM
    }
    SBAR();
#pragma unroll
    for (int hf = 0; hf < 2; ++hf) {
        { int lo_ = lane; asm volatile("" : "+v"(lo_));
#pragma unroll
          for (int i = 0; i < 4; ++i) *(LAS u32x4*)(stg + (8 * i + (lo_ >> 3)) * STG_ROW + (lo_ & 7) * 16) = gv[hf][i]; }
        stage_gated_out(stg, o2[2 * hf], o2[2 * hf + 1], Gout + go + 64 * hf, lane);
        if (hf == 0) { const int kl_ = k + 1 < nun ? k + 1 : k; MLA_COORDS(kl_, bl_, hl_, ql_); MLA_UQ_LOAD(bl_, hl_, ql_); }
    }
    if (k + 1 < nun) { MLA_COORDS(k + 1, bn_, hn_, qn_); MLA_UQ(bn_, hn_, qn_, 4); }
    }
#undef MLA_UQ
#undef MLA_UQ_LOAD
#undef MLA_WQ_DMA
#undef MLA_COORDS
#undef MLA_OFFS
#undef MLA_REQUEST
#undef MLA_DMA_K
#undef MLA_DMA_V
#undef MLA_DMA_K1
#undef MLA_DMA_R
#undef MLA_DMA_V1
}
}

#ifndef PH_MASK
#define PH_MASK 0x7fffu
#endif
#define PH_ON(k) ((PH_MASK >> (k)) & 1u)
#ifndef LB_WAVES
#define LB_WAVES 2
#endif
#ifndef PROBE_PHASE
#define PROBE_PHASE (-1)
#endif
__global__ void __launch_bounds__(NWAVES * 64, LB_WAVES) skel_fwd(Args args) {
    using namespace cfg;
    extern __shared__ __attribute__((aligned(16))) unsigned char lds[];
    Frame F;
    F.lds = (LAS unsigned char*)lds;
    F.MISC = (volatile LAS unsigned*)(F.lds + MISC_OFF);
    F.tid = threadIdx.x; F.lane = F.tid & 63; F.wave = __builtin_amdgcn_readfirstlane(F.tid >> 6);
    F.G = gridDim.x; { const int bx = blockIdx.x; F.vcu = (F.G % 8 == 0) ? (bx % 8) * (F.G / 8) + bx / 8 : bx; }
    unsigned char* ws = args.ws;
    for (int u = F.tid; u < (LDS_BYTES - LDSCTL_OFF) / 4; u += NWAVES * 64) ((LAS unsigned*)(F.lds + LDSCTL_OFF))[u] = 0u;
    __syncthreads();
    const int lo = args.ph_lo, hi = args.ph_hi;
    XcdBarrier bar; bar.bar = (unsigned*)(ws + WS_CTL) + CW_BAR + args.li * XCD_BAR_WORDS; bar.x = 0; bar.st = nullptr;
    if (hi - lo > 1) bar = xcd_barrier_post((unsigned*)(ws + WS_CTL) + CW_BAR + args.li * XCD_BAR_WORDS, F.MISC + 8);
#define IN(k) (lo <= (k) && (k) < hi)
#define SEAM(k) do { if (IN(k) && IN((k) + 1)) xcd_barrier(bar); } while (0)
    const bf16_t* xb = (const bf16_t*)(ws + WS_XB); float* ss = (float*)(ws + WS_SS);
    bf16_t* bA = (bf16_t*)(ws + WS_A); bf16_t* bB = (bf16_t*)(ws + WS_B); bf16_t* bC = (bf16_t*)(ws + WS_C); bf16_t* bG = (bf16_t*)(ws + WS_G);
    bf16_t* bQL = (bf16_t*)(ws + WS_QL); bf16_t* bKV2 = (bf16_t*)(ws + WS_KV2); float* ssq = (float*)(ws + WS_SSQ); float* sskv = (float*)(ws + WS_SSKV);
    const int bx = (int)blockIdx.x;
#define WPTR(off) ((const bf16_t*)(ws + WS_W + (off)))
#define OUT_PHASE(Aptr, Woff, XF32, F32O, LNEXT) do { pg8::Gemm g{(Aptr), WPTR(Woff), M, 1024, 1024}; pg8::StaticOrder So; So.init(M, 1024, F.G, bx); \
        pg8::EpiOutR<XF32, F32O> E{args.in[0], args.out, (bf16_t*)(ws + WS_XB), ss + (LNEXT) * M}; pg8::gemm_phase<pg8::EpiOutR<XF32, F32O>, pg8::StaticOrder, true, true>(F.lds + RING_OFF, g, So, E); } while (0)
#define SB_IN_PHASE(Wqkg, Wv, LYR) do { const float* ssl = ss + (LYR) * M; { pg8::Gemm g{xb, WPTR(Wqkg), M, 3072, 1024}; pg8::StaticOrder So; So.init(M, 3072, F.G, bx); \
          pg8::EpiSbQKG E{ssl, ws}; pg8::gemm_phase<pg8::EpiSbQKG, pg8::StaticOrder, true, true>(F.lds + RING_OFF, g, So, E); } \
        { pg8::Gemm g{WPTR(Wv), xb, 1024, M, 1024}; pg8::StaticOrder So; So.init(1024, M, F.G, bx); \
          pg8::EpiVt E{ssl, bC, 16}; pg8::gemm_phase<pg8::EpiVt, pg8::StaticOrder, true, true>(F.lds + RING_OFF, g, So, E); } } while (0)

    if (IN(0) && PH_ON(0)) { if (PROBE_PHASE == 0) p0_prologue(phase_frame(F), args); p0_prologue(phase_frame(F), args); SEAM(0); }
    if (IN(1) && PH_ON(1)) { if (PROBE_PHASE == 1) SB_IN_PHASE(W_L0_QKG, W_L0_V, 0); SB_IN_PHASE(W_L0_QKG, W_L0_V, 0); SEAM(1); }
    if (IN(2) && PH_ON(2)) { if (PROBE_PHASE == 2) att::sb_attn_phase(phase_frame(F), bA, bB, bC, bG, (bf16_t*)args.out); att::sb_attn_phase(phase_frame(F), bA, bB, bC, bG, bA); SEAM(2); }
    if (IN(3) && PH_ON(3)) { if (PROBE_PHASE == 3) OUT_PHASE(bA, W_L0_O, true, false, 1); OUT_PHASE(bA, W_L0_O, true, false, 1); SEAM(3); }
    if (IN(4) && PH_ON(4)) { for (int rep_ = (PROBE_PHASE == 4 ? 0 : 1); rep_ < 2; ++rep_) { pg8::Gemm g{xb, WPTR(W_L1_IN), M, 1536, 1024}; pg8::StaticOrder So; So.init(M, 1536, F.G, bx);
        pg8::EpiMlaIn E{ss + 1 * M, ws}; pg8::gemm_phase<pg8::EpiMlaIn, pg8::StaticOrder, true, true>(F.lds + RING_OFF, g, So, E); } SEAM(4); }
    if (IN(5) && PH_ON(5)) { for (int rep_ = (PROBE_PHASE == 5 ? 0 : 1); rep_ < 2; ++rep_) {
        { pg8::Gemm g{bKV2, WPTR(W_L1_UK), M, 1024, 256}; pg8::StaticOrder So; So.init(M, 1024, F.G, bx);
          pg8::EpiUkv E{sskv, bB, bC, (float*)(ws + WS_SSN)}; pg8::gemm_phase<pg8::EpiUkv, pg8::StaticOrder, true, true>(F.lds + RING_OFF, g, So, E); } }
        SEAM(5); }
    if (IN(6) && PH_ON(6)) { mla_prep(phase_frame(F), args); SEAM(6); }
    if (IN(7) && PH_ON(7)) { constexpr int nrep_ = PROBE_PHASE == 7 ? 2 : 1; for (int rep_ = 0; rep_ < nrep_; ++rep_) att::mla_attn_phase(phase_frame(F), bA, bG, rep_ == nrep_ - 1 ? bG : (bf16_t*)args.out, ws); SEAM(7); }
    if (IN(8) && PH_ON(8)) { OUT_PHASE(bG, W_L1_O, false, false, 2); SEAM(8); }
    if (IN(9) && PH_ON(9)) { for (int rep_ = (PROBE_PHASE == 9 ? 0 : 1); rep_ < 2; ++rep_) {
        { pg8::Gemm g{xb, WPTR(W_L2_QKG), M, 2304, 1024}; pg8::StaticOrder So; So.init(M, 2304, F.G, bx);
          pg8::EpiSwaQKG E{ss + 2 * M, args.in[15], args.in[16], ws}; pg8::gemm_phase<pg8::EpiSwaQKG, pg8::StaticOrder, true, true>(F.lds + RING_OFF, g, So, E); }
        { pg8::Gemm g{WPTR(W_L2_V), xb, 256, M, 1024}; pg8::StaticOrder So; So.init(256, M, F.G, (bx + F.G / 2) % F.G);
          pg8::EpiVt E{ss + 2 * M, bC, 4}; pg8::gemm_phase<pg8::EpiVt, pg8::StaticOrder, true, true>(F.lds + RING_OFF, g, So, E); } }
        SEAM(9); }
    if (IN(10) && PH_ON(10)) { if (PROBE_PHASE == 10) att::swa_attn_phase(phase_frame(F), bA, bB, bC, bG, args.in[17], (bf16_t*)args.out); att::swa_attn_phase(phase_frame(F), bA, bB, bC, bG, args.in[17], bA); SEAM(10); }
    if (IN(11) && PH_ON(11)) { OUT_PHASE(bA, W_L2_O, false, false, 3); SEAM(11); }
    if (IN(12) && PH_ON(12)) { SB_IN_PHASE(W_L3_QKG, W_L3_V, 3); SEAM(12); }
    if (IN(13) && PH_ON(13)) { att::sb_attn_phase(phase_frame(F), bA, bB, bC, bG, bA); SEAM(13); }
    if (IN(14) && PH_ON(14)) { OUT_PHASE(bA, W_L3_O, false, true, 0); }
#undef IN
#undef SEAM
#undef OUT_PHASE
#undef SB_IN_PHASE
#undef WPTR
}

extern "C" void kernel_launch(void* const* d_in, const int* in_sizes, int n_in, void* d_out, int out_size, void* d_ws, size_t ws_size, hipStream_t stream) {
    using namespace cfg;
    static int grid = 0;
    if (grid == 0) {
        if (n_in != 22 || in_sizes[0] != M * D || out_size != M * D || ws_size < WS_END) { fprintf(stderr, "kernel_launch: unexpected shapes (n_in %d, ws %zu); nothing launched\n", n_in, ws_size); grid = -1; return; }
        int dev = 0, cus = 0, per_cu = 0;
        if (hipGetDevice(&dev) != hipSuccess || hipDeviceGetAttribute(&cus, hipDeviceAttributeMultiprocessorCount, dev) != hipSuccess) { grid = -1; return; }
        if (hipFuncSetAttribute((const void*)skel_fwd, hipFuncAttributeMaxDynamicSharedMemorySize, LDS_BYTES) != hipSuccess) { fprintf(stderr, "kernel_launch: hipFuncSetAttribute failed\n"); grid = -1; return; }
        if (hipOccupancyMaxActiveBlocksPerMultiprocessor(&per_cu, (const void*)skel_fwd, NWAVES * 64, LDS_BYTES) != hipSuccess || per_cu < 1)
            fprintf(stderr, "kernel_launch: note: occupancy query reports %d workgroups per CU\n", per_cu);
        (void)hipGetLastError();
        grid = cus;
    }
    if (grid < 0) return;
    if (hipMemsetAsync((char*)d_ws + WS_CTL, 0, CTL_ZERO_BYTES, stream) != hipSuccess) return;
    Args a{};
    for (int i = 0; i < 22; ++i) a.in[i] = (const float*)d_in[i];
    a.out = (float*)d_out; a.ws = (unsigned char*)d_ws;
    a.ph_lo = 0; a.ph_hi = N_PHASES; a.li = 0;
    hipLaunchKernelGGL(skel_fwd, dim3(grid), dim3(NWAVES * 64), LDS_BYTES, stream, a);
}
```
